# Optimizing an MI355X kernel written in HIP

```python
import math
import jax, jax.numpy as jnp
from jax import lax
import numpy as np

D_MODEL = 1024
BATCH = 4
SEQ = 4096
DEPTH = 2
DEC_BATCH = 2
DEC_SEQ = 16384
PAST_LEN = 128

HEAD_DIM = 64
MIX_WIDTH = D_MODEL
NA_HEADS = (MIX_WIDTH // 2) // HEAD_DIM
NA_WIDTH = NA_HEADS * HEAD_DIM
GRID_W = 64
NA_WIN_ROWS = 8
NA_WIN_COLS = 16
POOL_WIDTH = MIX_WIDTH - NA_WIDTH
POOL_WINDOWS = (2, 4, 8, 16)
POOL_GROUPS = len(POOL_WINDOWS)
POOL_GROUP_DIM = POOL_WIDTH // POOL_GROUPS
EVEN_IN = 3 * NA_WIDTH + POOL_WIDTH
SWA_HEADS = 8
SWA_KV_HEADS = 2
SWA_WIDTH = SWA_HEADS * HEAD_DIM
SWA_KV_WIDTH = SWA_KV_HEADS * HEAD_DIM
SWA_WINDOW = 128
SWA_BLOCK = 128
CONV_WIDTH = MIX_WIDTH - SWA_WIDTH
CONV_K = 3
ODD_IN = SWA_WIDTH + 2 * SWA_KV_WIDTH + 3 * CONV_WIDTH
D_FF = -(-(8 * D_MODEL) // (3 * 256)) * 256
ROPE_THETA = 10000.0
EPS = 1e-6
N_EVEN = (DEPTH + 1) // 2
N_ODD = DEPTH // 2

kernel_name = "hybrid_natten_pool_swa_conv_encoder"


def _rmsnorm(x, g):
    xf = x.astype(jnp.float32)
    y = xf * lax.rsqrt(jnp.mean(xf * xf, axis=-1, keepdims=True) + EPS)
    return (y * g.astype(jnp.float32)).astype(x.dtype)


def _modulate(h, shift, scale):
    return h * (1 + scale[:, None, :]) + shift[:, None, :]


def _rope(x):
    L = x.shape[1]
    inv = 1.0 / (ROPE_THETA ** (jnp.arange(0, HEAD_DIM, 2, dtype=jnp.float32) / HEAD_DIM))
    ang = jnp.arange(L, dtype=jnp.float32)[:, None] * inv[None, :]
    cos = jnp.cos(ang)[None, :, None, :]
    sin = jnp.sin(ang)[None, :, None, :]
    x1, x2 = jnp.split(x.astype(jnp.float32), 2, axis=-1)
    out = jnp.concatenate([x1 * cos - x2 * sin, x1 * sin + x2 * cos], axis=-1)
    return out.astype(x.dtype)


def _neighbourhood_attention(q, k, v, rpb):
    B, L, H, Dh = q.shape
    rows = L // GRID_W
    wr = min(NA_WIN_ROWS, rows)
    r = jnp.arange(rows)
    row_start = jnp.clip(r - wr // 2, 0, rows - wr)
    key_rows = row_start[:, None] + jnp.arange(wr)[None, :]
    cq = jnp.arange(GRID_W)
    col_start = jnp.clip(cq - NA_WIN_COLS // 2, 0, GRID_W - NA_WIN_COLS)
    kc = jnp.arange(GRID_W)
    col_ok = (kc[None, :] >= col_start[:, None]) & (kc[None, :] < col_start[:, None] + NA_WIN_COLS)
    qg = q.reshape(B, rows, GRID_W, H, Dh)
    kg = k.reshape(B, rows, GRID_W, H, Dh)[:, key_rows]
    vg = v.reshape(B, rows, GRID_W, H, Dh)[:, key_rows]
    s = jnp.einsum('brqhd,brikhd->bhrqik', qg, kg).astype(jnp.float32) * (Dh ** -0.5)
    dr = key_rows - r[:, None] + (NA_WIN_ROWS - 1)
    dc = jnp.clip(kc[None, :] - cq[:, None], -(NA_WIN_COLS - 1), NA_WIN_COLS - 1) + (NA_WIN_COLS - 1)
    bias = rpb.astype(jnp.float32)[:, dr][..., dc]
    bias = bias.transpose(0, 1, 3, 2, 4)
    s = jnp.where(col_ok[None, None, None, :, None, :], s + bias[None], -jnp.inf)
    p = jax.nn.softmax(s.reshape(B, H, rows, GRID_W, wr * GRID_W), axis=-1)
    p = p.reshape(B, H, rows, GRID_W, wr, GRID_W).astype(v.dtype)
    out = jnp.einsum('bhrqik,brikhd->brqhd', p, vg)
    return out.reshape(B, L, H * Dh)


def _multiscale_pool(u, w_grp, scale):
    B, L, _ = u.shape
    ug = u.reshape(B, L, POOL_GROUPS, POOL_GROUP_DIM)
    cs = jnp.cumsum(ug.astype(jnp.float32), axis=1)
    cs = jnp.pad(cs, ((0, 0), (1, 0), (0, 0), (0, 0)))
    t = jnp.arange(L)
    pooled = []
    for g, w in enumerate(POOL_WINDOWS):
        lo = jnp.clip(t - w // 2, 0, L)
        hi = jnp.clip(t - w // 2 + w, 0, L)
        csg = cs[:, :, g]
        cnt = (hi - lo).astype(jnp.float32)[None, :, None]
        pooled.append((csg[:, hi] - csg[:, lo]) / cnt)
    mixed = jnp.stack(pooled, axis=2) - ug.astype(jnp.float32)
    y = jnp.einsum('blgc,gce->blge', mixed.astype(u.dtype), w_grp)
    return y.reshape(B, L, POOL_WIDTH) * scale


def _window_gqa_sink(q, k, v, sink):
    B, L, Hq, Dh = q.shape
    Hkv = k.shape[2]
    G = Hq // Hkv
    nb = L // SWA_BLOCK
    qb = q.reshape(B, nb, SWA_BLOCK, Hkv, G, Dh)
    pad = ((0, 0), (SWA_BLOCK, SWA_BLOCK), (0, 0), (0, 0))
    kp = jnp.pad(k, pad)
    vp = jnp.pad(v, pad)
    idx = jnp.arange(nb)[:, None] * SWA_BLOCK + jnp.arange(3 * SWA_BLOCK)[None, :]
    kb = kp[:, idx]
    vb = vp[:, idx]
    s = jnp.einsum('bnqhgd,bnkhd->bhgnqk', qb, kb).astype(jnp.float32) * (Dh ** -0.5)
    qpos = jnp.arange(nb)[:, None] * SWA_BLOCK + jnp.arange(SWA_BLOCK)[None, :]
    kpos = idx - SWA_BLOCK
    ok = (jnp.abs(qpos[:, :, None] - kpos[:, None, :]) <= SWA_WINDOW) & (kpos >= 0)[:, None, :] & (kpos < L)[:, None, :]
    s = jnp.where(ok[None, None, None], s, -jnp.inf)
    sink_l = sink.astype(jnp.float32).reshape(Hkv, G)[None, :, :, None, None, None]
    m = jnp.maximum(jnp.max(s, axis=-1, keepdims=True), sink_l)
    e = jnp.exp(s - m)
    p = e / (jnp.sum(e, axis=-1, keepdims=True) + jnp.exp(sink_l - m))
    out = jnp.einsum('bhgnqk,bnkhd->bnqhgd', p.astype(v.dtype), vb)
    return out.reshape(B, L, Hq * Dh)


def _gated_short_conv(bg, cg, xin, w, b):
    u = cg * xin
    L = u.shape[1]
    up = jnp.pad(u, ((0, 0), (CONV_K // 2, CONV_K // 2), (0, 0)))
    conv = b
    for j in range(CONV_K):
        conv = conv + up[:, j:j + L] * w[j]
    return bg * conv


def _even_mixer(h, w_in, rpb, pool_w, pool_scale, w_out):
    B, L, _ = h.shape
    z = h @ w_in
    q, k, v, u = jnp.split(z, [NA_WIDTH, 2 * NA_WIDTH, 3 * NA_WIDTH], axis=-1)
    shp = (B, L, NA_HEADS, HEAD_DIM)
    a = _neighbourhood_attention(q.reshape(shp), k.reshape(shp), v.reshape(shp), rpb)
    p = _multiscale_pool(u, pool_w, pool_scale)
    return jnp.concatenate([a, p], axis=-1) @ w_out


def _odd_mixer(h, w_in, sink, conv_w, conv_b, w_out):
    B, L, _ = h.shape
    z = h @ w_in
    s1 = SWA_WIDTH
    s2 = s1 + SWA_KV_WIDTH
    s3 = s2 + SWA_KV_WIDTH
    s4 = s3 + CONV_WIDTH
    s5 = s4 + CONV_WIDTH
    q, k, v, bg, cg, xin = jnp.split(z, [s1, s2, s3, s4, s5], axis=-1)
    q = _rope(q.reshape(B, L, SWA_HEADS, HEAD_DIM))
    k = _rope(k.reshape(B, L, SWA_KV_HEADS, HEAD_DIM))
    v = v.reshape(B, L, SWA_KV_HEADS, HEAD_DIM)
    a = _window_gqa_sink(q, k, v, sink)
    d = _gated_short_conv(bg, cg, xin, conv_w, conv_b)
    return jnp.concatenate([a, d], axis=-1) @ w_out


def _swiglu(h, w1, w3, w2):
    return (jax.nn.silu(h @ w1) * (h @ w3)) @ w2


def _trunk(x, c, ada_w, ada_b, norm_g, final_g, ffn_w1, ffn_w3, ffn_w2,
           even_w_in, na_rpb, pool_w, pool_scale, even_w_out,
           odd_w_in, swa_sink, conv_w, conv_b, odd_w_out):
    c_act = jax.nn.silu(c)
    for i in range(DEPTH):
        mod = c_act @ ada_w[i] + ada_b[i]
        sh1, sc1, g1, sh2, sc2, g2 = jnp.split(mod, 6, axis=-1)
        h = _modulate(_rmsnorm(x, norm_g[i, 0]), sh1, sc1)
        j = i // 2
        if i % 2 == 0:
            mix = _even_mixer(h, even_w_in[j], na_rpb[j], pool_w[j], pool_scale[j], even_w_out[j])
        else:
            mix = _odd_mixer(h, odd_w_in[j], swa_sink[j], conv_w[j], conv_b[j], odd_w_out[j])
        x = x + g1[:, None, :] * mix
        h = _modulate(_rmsnorm(x, norm_g[i, 1]), sh2, sc2)
        x = x + g2[:, None, :] * _swiglu(h, ffn_w1[i], ffn_w3[i], ffn_w2[i])
    return _rmsnorm(x, final_g)


def setup_inputs(seed: int = 0) -> dict:
    key = jax.random.key(seed)
    ks = jax.random.split(key, 24)
    f32 = jnp.float32
    n = lambda k, s: jax.random.normal(k, s, dtype=f32)
    D = D_MODEL
    return {
        "x_prompt": n(ks[0], (BATCH, SEQ, D)),
        "x_sample": n(ks[1], (DEC_BATCH, DEC_SEQ, D)),
        "c_prompt": n(ks[2], (BATCH, D)),
        "c_sample": n(ks[3], (DEC_BATCH, D)),
        "ada_w": n(ks[4], (DEPTH, D, 6 * D)) * (0.5 * D ** -0.5),
        "ada_b": n(ks[5], (DEPTH, 6 * D)) * 0.01,
        "norm_g": 1.0 + 0.01 * n(ks[6], (DEPTH, 2, D)),
        "final_g": 1.0 + 0.01 * n(ks[7], (D,)),
        "ffn_w1": n(ks[8], (DEPTH, D, D_FF)) * D ** -0.5,
        "ffn_w3": n(ks[9], (DEPTH, D, D_FF)) * D ** -0.5,
        "ffn_w2": n(ks[10], (DEPTH, D_FF, D)) * D_FF ** -0.5,
        "even_w_in": n(ks[11], (N_EVEN, D, EVEN_IN)) * D ** -0.5,
        "na_rpb": n(ks[12], (N_EVEN, NA_HEADS, 2 * NA_WIN_ROWS - 1, 2 * NA_WIN_COLS - 1)) * 0.1,
        "pool_w": n(ks[13], (N_EVEN, POOL_GROUPS, POOL_GROUP_DIM, POOL_GROUP_DIM)) * POOL_GROUP_DIM ** -0.5,
        "pool_scale": 1.0 + 0.02 * n(ks[14], (N_EVEN, POOL_WIDTH)),
        "even_w_out": n(ks[15], (N_EVEN, MIX_WIDTH, D)) * MIX_WIDTH ** -0.5,
        "odd_w_in": n(ks[16], (N_ODD, D, ODD_IN)) * D ** -0.5,
        "swa_sink": n(ks[17], (N_ODD, SWA_HEADS)) * 0.5,
        "conv_w": n(ks[18], (N_ODD, CONV_K, CONV_WIDTH)) * CONV_K ** -0.5,
        "conv_b": n(ks[19], (N_ODD, CONV_WIDTH)) * 0.01,
        "odd_w_out": n(ks[20], (N_ODD, MIX_WIDTH, D)) * MIX_WIDTH ** -0.5,
    }


def reference(x_prompt, x_sample, c_prompt, c_sample, ada_w, ada_b, norm_g, final_g,
              ffn_w1, ffn_w3, ffn_w2, even_w_in, na_rpb, pool_w, pool_scale, even_w_out,
              odd_w_in, swa_sink, conv_w, conv_b, odd_w_out):
    y_prompt = _trunk(x_prompt, c_prompt, ada_w, ada_b, norm_g, final_g, ffn_w1, ffn_w3, ffn_w2,
                      even_w_in, na_rpb, pool_w, pool_scale, even_w_out,
                      odd_w_in, swa_sink, conv_w, conv_b, odd_w_out)
    y_sample = _trunk(x_sample, c_sample, ada_w, ada_b, norm_g, final_g, ffn_w1, ffn_w3, ffn_w2,
                      even_w_in, na_rpb, pool_w, pool_scale, even_w_out,
                      odd_w_in, swa_sink, conv_w, conv_b, odd_w_out)
    return (y_prompt, y_sample)
```

```cpp
#include <hip/hip_runtime.h>
#include <hip/hip_cooperative_groups.h>
#include <cstdio>
#include <cstdint>
namespace cg = cooperative_groups;
namespace pg8 {
#define PG8_LAS __attribute__((address_space(3)))
typedef unsigned short bf16_t;
typedef short bf16x8 __attribute__((ext_vector_type(8)));
typedef float f32x4 __attribute__((ext_vector_type(4)));
typedef unsigned u32x4 __attribute__((ext_vector_type(4)));
constexpr int BM = 256, BK = 64, HALF = 128, HTB = HALF * BK * 2  , STAGE_BYTES = 8 * HTB, NXCD = 8, WGM = 8;

__host__ __device__ __forceinline__ int lds_byte(int r, int c) { const int st = (r >> 4) * 2 + (c >> 5), rr = r & 15, cc = c & 31, ob = rr * 64 + cc * 2; return st * 1024 + (ob ^ (((ob >> 9) & 1) << 5)); }
__host__ __device__ __forceinline__ void stage_rc(int b, int& R, int& C) { const int st = b / 1024, sb = b % 1024, swz = sb ^ (((sb >> 9) & 1) << 5); R = (st >> 1) * 16 + swz / 64; C = (st & 1) * 32 + (swz % 64) / 2; }
__host__ __device__ __forceinline__ int perm32(int rho) { const int n = rho >> 4, i = rho & 15; return 8 * (i >> 2) + 4 * n + (i & 3); }

struct Unit { int pm, pn; };
struct Gemm { const bf16_t* A; const bf16_t* Bt; int M, N, K; };

struct StaticOrder {
    int nM, nN, nwg, G, c;
    __host__ __device__ void init(int M, int N, int G_, int c_) { nM = M / BM; nN = N / BM; nwg = nM * nN; G = G_; c = c_; }
    __host__ __device__ bool next(int i, Unit& u) const {
        const long L = (long)i * G + c; if (L >= nwg) return false;
        int wgid = (int)L; { const int q = nwg / NXCD, r = nwg % NXCD, xcd = wgid % NXCD, off = wgid / NXCD; wgid = (xcd < r ? xcd * (q + 1) : r * (q + 1) + (xcd - r) * q) + off; }
        const int nig = WGM * nN, gid = wgid / nig, fm = gid * WGM, gsz = (nM - fm) < WGM ? (nM - fm) : WGM;
        u.pm = fm + ((wgid % nig) % gsz); u.pn = (wgid % nig) / gsz; return true;
    }
    __device__ __forceinline__ void a_ready(const Unit&) const {}
    __device__ __forceinline__ void done(const Unit&) const {}
};

typedef float f32x2_t __attribute__((ext_vector_type(2))); typedef __bf16 bf16x2_t __attribute__((ext_vector_type(2)));
__device__ __forceinline__ unsigned cvt_pk_bf16(float lo, float hi) { f32x2_t v = {lo, hi}; bf16x2_t b = __builtin_convertvector(v, bf16x2_t); return __builtin_bit_cast(unsigned, b); }

struct EpiBf16R {
    static constexpr bool PERM = true, AFTER_DRAIN = false;
    bf16_t* O; int ldc; int rope_cols; const float* cosT; const float* sinT;
    __device__ __forceinline__ void operator()(const f32x4 (&acc)[2][2][4][2], const Unit& u, int wr, int wc, int fr, int fq) const {
        const int row0 = u.pm * BM + wr * 64 + fr; const int col0 = u.pn * BM + wc * 32 + 8 * fq;
#pragma unroll
        for (int ai = 0; ai < 2; ++ai)
#pragma unroll
            for (int m = 0; m < 4; ++m) { const int row = row0 + ai * HALF + m * 16; bf16_t* rowp = O + (size_t)row * ldc + col0; const int pos = row & 16383 & (row < 16384 ? 4095 : 16383);
#pragma unroll
                for (int bj = 0; bj < 2; ++bj) { f32x4 v0 = acc[ai][bj][m][0], v1 = acc[ai][bj][m][1];
                    const int c = col0 + bj * HALF;
                    if (c < rope_cols) { const int i0 = (c & 63) >> 1; const f32x4 cs = *(const f32x4*)(cosT + (size_t)pos * 32 + i0), sn = *(const f32x4*)(sinT + (size_t)pos * 32 + i0);
                        f32x4 w0, w1;
                        w0[0] = v0[0] * cs[0] - v0[1] * sn[0]; w0[1] = v0[0] * sn[0] + v0[1] * cs[0];
                        w0[2] = v0[2] * cs[1] - v0[3] * sn[1]; w0[3] = v0[2] * sn[1] + v0[3] * cs[1];
                        w1[0] = v1[0] * cs[2] - v1[1] * sn[2]; w1[1] = v1[0] * sn[2] + v1[1] * cs[2];
                        w1[2] = v1[2] * cs[3] - v1[3] * sn[3]; w1[3] = v1[2] * sn[3] + v1[3] * cs[3];
                        v0 = w0; v1 = w1; }
                    u32x4 w; w.x = cvt_pk_bf16(v0[0], v0[1]); w.y = cvt_pk_bf16(v0[2], v0[3]); w.z = cvt_pk_bf16(v1[0], v1[1]); w.w = cvt_pk_bf16(v1[2], v1[3]);
                    *(u32x4*)(rowp + bj * HALF) = w; } }
    }
};
__device__ __forceinline__ float silu_f(float x) { return x * __builtin_amdgcn_rcpf(1.0f + __builtin_amdgcn_exp2f(-1.4426950408889634f * x)); }
struct EpiSwiGLU {
    static constexpr bool PERM = true, AFTER_DRAIN = false;
    bf16_t* O; int ldc;
    __device__ __forceinline__ void operator()(const f32x4 (&acc)[2][2][4][2], const Unit& u, int wr, int wc, int fr, int fq) const {
        const int row0 = u.pm * BM + wr * 64 + fr; const int col0 = u.pn * HALF + wc * 32 + 8 * fq;
#pragma unroll
        for (int ai = 0; ai < 2; ++ai)
#pragma unroll
            for (int m = 0; m < 4; ++m) { bf16_t* rowp = O + (size_t)(row0 + ai * HALF + m * 16) * ldc + col0;
                const f32x4 g0 = acc[ai][0][m][0], g1 = acc[ai][0][m][1], u0 = acc[ai][1][m][0], u1 = acc[ai][1][m][1];
                u32x4 w; w.x = cvt_pk_bf16(silu_f(g0[0]) * u0[0], silu_f(g0[1]) * u0[1]); w.y = cvt_pk_bf16(silu_f(g0[2]) * u0[2], silu_f(g0[3]) * u0[3]);
                w.z = cvt_pk_bf16(silu_f(g1[0]) * u1[0], silu_f(g1[1]) * u1[1]); w.w = cvt_pk_bf16(silu_f(g1[2]) * u1[2], silu_f(g1[3]) * u1[3]);
                *(u32x4*)rowp = w; }
    }
};
struct EpiRes {
    static constexpr bool PERM = false, AFTER_DRAIN = false;
    const float* srcA; const float* srcB; float* out; const float* gate;
    __device__ __forceinline__ void operator()(const f32x4 (&acc)[2][2][4][2], const Unit& u, int wr, int wc, int fr, int fq) const {
        const int rbase = u.pm * BM; const int row0 = rbase + wr * 64 + fr, col0 = u.pn * BM + wc * 32 + 4 * fq;
        const int b = rbase < 16384 ? (rbase >> 12) : 4 + ((rbase - 16384) >> 14);
        const float* src = rbase < 16384 ? srcA : srcB - (size_t)16384 * 1024;
        const float* g = gate + (size_t)b * 6144 + col0;
        f32x4 gv[2][2];
#pragma unroll
        for (int bj = 0; bj < 2; ++bj)
#pragma unroll
            for (int n = 0; n < 2; ++n) gv[bj][n] = *(const f32x4*)(g + bj * HALF + n * 16);
#pragma unroll
        for (int ai = 0; ai < 2; ++ai)
#pragma unroll
            for (int m = 0; m < 4; ++m) { const size_t off = (size_t)(row0 + ai * HALF + m * 16) * 1024 + col0;
#pragma unroll
                for (int bj = 0; bj < 2; ++bj)
#pragma unroll
                    for (int n = 0; n < 2; ++n) { const f32x4 s = *(const f32x4*)(src + off + bj * HALF + n * 16); *(f32x4*)(out + off + bj * HALF + n * 16) = s + gv[bj][n] * acc[ai][bj][m][n]; } }
    }
};

template <class Epi, class Sched, bool ALIGN_EPI = false, bool SP2 = false>
__device__ __forceinline__ void gemm_phase(PG8_LAS unsigned char* lds, const Gemm g, const Sched& S, const Epi& E) {
    int tid_ = threadIdx.x; asm volatile("" : "+v"(tid_));
    const int tid = tid_, wid = __builtin_amdgcn_readfirstlane(tid >> 6), lane = tid & 63, wr = wid >> 2, wc = wid & 3, fr = lane & 15, fq = lane >> 4;
    const int K = g.K, nt = K / BK;
    unsigned voffA[2], voffB[2];
#pragma unroll
    for (int i = 0; i < 2; ++i) { int R, C; stage_rc(tid * 16 + i * 8192, R, C); const int Rb = Epi::PERM ? ((R & ~31) + perm32(R & 31)) : R;
        voffA[i] = (unsigned)(R * K + C) * 2u; voffB[i] = (unsigned)(Rb * K + C) * 2u; }
    const size_t kstep = (size_t)(BK * 2);
    const size_t hstep = (size_t)HALF * K * 2;
    const size_t tstep = 2 * hstep;
    const unsigned ldsw = (unsigned)wid * 1024u;
    const int aoff = lds_byte(wr * 64 + fr, fq * 8), boff = lds_byte(wc * 32 + fr, fq * 8);
#define PG8_SA(b, h) (((b) * 2 + (h)) * HTB)
#define PG8_SB(b, h) ((4 + (b) * 2 + (h)) * HTB)
#define PG8_STAGE(bufoff, gbase, voff) do { _Pragma("unroll") for (int _i = 0; _i < 2; ++_i) \
        __builtin_amdgcn_global_load_lds((const unsigned*)((const char*)(gbase) + (voff)[_i]), (PG8_LAS unsigned*)(lds + (bufoff) + ldsw + _i * 8192), 16, 0, 0); } while (0)
#define PG8_LDA(dst, b, h) do { _Pragma("unroll") for (int m = 0; m < 4; ++m) _Pragma("unroll") for (int k = 0; k < 2; ++k) dst[m][k] = *(const PG8_LAS bf16x8*)(lds + PG8_SA(b, h) + aoff + m * 2048 + k * 1024); } while (0)
#define PG8_LDB(dst, b, h) do { _Pragma("unroll") for (int n = 0; n < 2; ++n) _Pragma("unroll") for (int k = 0; k < 2; ++k) dst[n][k] = *(const PG8_LAS bf16x8*)(lds + PG8_SB(b, h) + boff + n * 2048 + k * 1024); } while (0)
#define PG8_MMA(ai, bj, At, Bt) do { __builtin_amdgcn_s_setprio(1); _Pragma("unroll") for (int m = 0; m < 4; ++m) _Pragma("unroll") for (int n = 0; n < 2; ++n) _Pragma("unroll") for (int k = 0; k < 2; ++k) \
        acc[ai][bj][m][n] = __builtin_amdgcn_mfma_f32_16x16x32_bf16(Bt[n][k], At[m][k], acc[ai][bj][m][n], 0, 0, 0); __builtin_amdgcn_s_setprio(0); } while (0)
#define PG8_WAIT_V(n) asm volatile("s_waitcnt vmcnt(" #n ")" ::: "memory")
#define PG8_WAIT_L(n) asm volatile("s_waitcnt lgkmcnt(" #n ")" ::: "memory")
#define PG8_BAR __builtin_amdgcn_s_barrier()
#define PG8_SCHED __builtin_amdgcn_sched_barrier(0)
    Unit cur, nxt; int ui = 0;
    if (!S.next(0, cur)) return;
    f32x4 acc[2][2][4][2];
#pragma unroll
    for (int a = 0; a < 2; ++a)
#pragma unroll
        for (int b = 0; b < 2; ++b)
#pragma unroll
            for (int m = 0; m < 4; ++m)
#pragma unroll
                for (int n = 0; n < 2; ++n) acc[a][b][m][n] = (f32x4){0.f, 0.f, 0.f, 0.f};
    bf16x8 At[4][2], B0[2][2], B1[2][2];
    const char* cA = (const char*)g.A + (size_t)cur.pm * tstep; const char* cB = (const char*)g.Bt + (size_t)cur.pn * tstep;
    S.a_ready(cur);
    if constexpr (SP2) {
        PG8_STAGE(PG8_SB(0, 0), cB, voffB); PG8_STAGE(PG8_SB(0, 1), cB + hstep, voffB); PG8_STAGE(PG8_SA(0, 0), cA, voffA); PG8_STAGE(PG8_SA(0, 1), cA + hstep, voffA);
        if (wr == 1) PG8_BAR;
        PG8_WAIT_V(2); PG8_BAR;
        PG8_STAGE(PG8_SB(1, 0), cB + kstep, voffB); PG8_STAGE(PG8_SA(1, 0), cA + kstep, voffA); PG8_STAGE(PG8_SB(1, 1), cB + hstep + kstep, voffB);
        PG8_WAIT_V(6); PG8_BAR;
    } else {
        PG8_STAGE(PG8_SB(0, 0), cB, voffB); PG8_STAGE(PG8_SA(0, 0), cA, voffA); PG8_STAGE(PG8_SB(0, 1), cB + hstep, voffB); PG8_STAGE(PG8_SA(0, 1), cA + hstep, voffA);
        if (wr == 1) PG8_BAR;
        PG8_WAIT_V(4); PG8_BAR;
        PG8_STAGE(PG8_SB(1, 0), cB + kstep, voffB); PG8_STAGE(PG8_SA(1, 0), cA + kstep, voffA); PG8_STAGE(PG8_SB(1, 1), cB + hstep + kstep, voffB);
        PG8_WAIT_V(6); PG8_BAR;
    }
    for (;;) {
        const bool has_next = S.next(ui + 1, nxt);
        const char* nA = has_next ? (const char*)g.A + (size_t)nxt.pm * tstep : cA; const char* nB = has_next ? (const char*)g.Bt + (size_t)nxt.pn * tstep : cB;
        for (int t = 0; t < nt; t += 2) {
            const bool last = (t == nt - 2);
            const char* a1 = cA + (size_t)(t + 1) * kstep;
            const char* a2 = last ? nA : cA + (size_t)(t + 2) * kstep; const char* b2 = last ? nB : cB + (size_t)(t + 2) * kstep;
            const char* a3 = a2 + kstep; const char* b3 = b2 + kstep;
            if (last && has_next) S.a_ready(nxt);
            if constexpr (SP2) {
            PG8_LDB(B0, 0, 0); PG8_LDB(B1, 0, 1); PG8_SCHED; PG8_LDA(At, 0, 0); PG8_STAGE(PG8_SA(1, 1), a1 + hstep, voffA);
            PG8_WAIT_V(8); PG8_WAIT_L(0); PG8_BAR; PG8_MMA(0, 0, At, B0); PG8_MMA(0, 1, At, B1); PG8_BAR; PG8_SCHED;
            PG8_LDA(At, 0, 1); PG8_STAGE(PG8_SB(0, 0), b2, voffB); PG8_STAGE(PG8_SB(0, 1), b2 + hstep, voffB); PG8_STAGE(PG8_SA(0, 0), a2, voffA);
            PG8_WAIT_V(8); PG8_WAIT_L(0); PG8_BAR; PG8_MMA(1, 0, At, B0); PG8_MMA(1, 1, At, B1); PG8_BAR; PG8_SCHED;
            PG8_LDB(B0, 1, 0); PG8_LDB(B1, 1, 1); PG8_SCHED; PG8_LDA(At, 1, 0); PG8_STAGE(PG8_SA(0, 1), a2 + hstep, voffA);
            PG8_WAIT_V(8); PG8_WAIT_L(0); PG8_BAR; PG8_MMA(0, 0, At, B0); PG8_MMA(0, 1, At, B1); PG8_BAR; PG8_SCHED;
            PG8_LDA(At, 1, 1); PG8_STAGE(PG8_SB(1, 0), b3, voffB); PG8_STAGE(PG8_SB(1, 1), b3 + hstep, voffB); PG8_STAGE(PG8_SA(1, 0), a3, voffA);
            PG8_WAIT_V(8); PG8_WAIT_L(0); PG8_BAR; PG8_MMA(1, 0, At, B0); PG8_MMA(1, 1, At, B1); PG8_BAR; PG8_SCHED;
            } else {
            PG8_LDB(B0, 0, 0); PG8_SCHED; PG8_LDA(At, 0, 0); PG8_STAGE(PG8_SA(1, 1), a1 + hstep, voffA);
            PG8_WAIT_L(8); PG8_BAR; PG8_WAIT_L(0); PG8_MMA(0, 0, At, B0); PG8_BAR; PG8_SCHED;
            PG8_LDB(B1, 0, 1); PG8_STAGE(PG8_SB(0, 0), b2, voffB);
            PG8_BAR; PG8_WAIT_L(0); PG8_MMA(0, 1, At, B1); PG8_BAR;
            PG8_LDA(At, 0, 1); PG8_STAGE(PG8_SA(0, 0), a2, voffA);
            PG8_BAR; PG8_WAIT_L(0); PG8_MMA(1, 0, At, B0); PG8_BAR; PG8_SCHED;
            PG8_STAGE(PG8_SB(0, 1), b2 + hstep, voffB);
            PG8_WAIT_V(6); PG8_BAR; PG8_MMA(1, 1, At, B1); PG8_BAR;
            PG8_LDB(B0, 1, 0); PG8_SCHED; PG8_LDA(At, 1, 0); PG8_STAGE(PG8_SA(0, 1), a2 + hstep, voffA);
            PG8_WAIT_L(8); PG8_BAR; PG8_WAIT_L(0); PG8_MMA(0, 0, At, B0); PG8_BAR; PG8_SCHED;
            PG8_LDB(B1, 1, 1); PG8_STAGE(PG8_SB(1, 0), b3, voffB);
            PG8_BAR; PG8_WAIT_L(0); PG8_MMA(0, 1, At, B1); PG8_BAR;
            PG8_LDA(At, 1, 1); PG8_STAGE(PG8_SA(1, 0), a3, voffA);
            PG8_BAR; PG8_WAIT_L(0); PG8_MMA(1, 0, At, B0); PG8_BAR; PG8_SCHED;
            PG8_STAGE(PG8_SB(1, 1), b3 + hstep, voffB);
            PG8_WAIT_V(6); PG8_BAR; PG8_MMA(1, 1, At, B1); PG8_BAR;
            }
        }
        if constexpr (ALIGN_EPI) { if (wr == 0) PG8_BAR; }
        if constexpr (!Epi::AFTER_DRAIN) { E(acc, cur, wr, wc, fr, fq); S.done(cur); }
        if (!has_next) break;
#pragma unroll
        for (int a = 0; a < 2; ++a)
#pragma unroll
            for (int b = 0; b < 2; ++b)
#pragma unroll
                for (int m = 0; m < 4; ++m)
#pragma unroll
                    for (int n = 0; n < 2; ++n) acc[a][b][m][n] = (f32x4){0.f, 0.f, 0.f, 0.f};
        cur = nxt; cA = nA; cB = nB; ++ui;
        if constexpr (ALIGN_EPI) { if (wr == 1) PG8_BAR; }
    }
    PG8_WAIT_V(0);
    if constexpr (!ALIGN_EPI) { if (wr == 0) PG8_BAR; }
    PG8_BAR;
    if constexpr (Epi::AFTER_DRAIN) { E.fused(acc, cur, wr, wc, fr, fq, lds, wid, lane); S.done(cur); }
#undef PG8_SA
#undef PG8_SB
#undef PG8_STAGE
#undef PG8_LDA
#undef PG8_LDB
#undef PG8_MMA
#undef PG8_WAIT_V
#undef PG8_WAIT_L
#undef PG8_BAR
#undef PG8_SCHED
}
}

constexpr int D = 1024, TP = 16384, TS = 32768, T = TP + TS, LP = 4096, LS = 16384, NB = 6, DFF = 2816;
constexpr int EVEN_IN = 2048, ODD_IN = 2304;
constexpr float EPS = 1e-6f, LOG2E = 1.4426950408889634f;
constexpr int NWAVES = 8;
constexpr size_t MiB = 1u << 20;
constexpr size_t WS_MOD = 0;
constexpr size_t WS_COS = 1 * MiB, WS_SIN = 3 * MiB;
constexpr size_t WS_WINE = 6 * MiB;
constexpr size_t WS_WOE = 10 * MiB;
constexpr size_t WS_WINO = 12 * MiB;
constexpr size_t WS_WOO = 17 * MiB;
constexpr size_t WS_W13 = 19 * MiB;
constexpr size_t WS_W2 = 41 * MiB;
constexpr size_t WS_PW = 52 * MiB;
constexpr size_t WS_HA = 54 * MiB;
constexpr size_t WS_ZR = 150 * MiB;
constexpr size_t WS_END = 414 * MiB;
constexpr int LDS_BYTES = 147456;

#define LAS __attribute__((address_space(3)))
typedef unsigned short bf16;
typedef unsigned v4u __attribute__((ext_vector_type(4)));
typedef unsigned v2u __attribute__((ext_vector_type(2)));
typedef float f32x4 __attribute__((ext_vector_type(4)));
typedef float f32x16 __attribute__((ext_vector_type(16)));
typedef short bf16x8 __attribute__((ext_vector_type(8)));
typedef short s16x4 __attribute__((ext_vector_type(4)));
#define LDS_WAIT() asm volatile("s_waitcnt lgkmcnt(0)" ::: "memory")
__device__ __forceinline__ unsigned f2bf(float f) { unsigned u = __builtin_bit_cast(unsigned, f); return (u + 0x7fffu + ((u >> 16) & 1u)) >> 16; }
__device__ __forceinline__ unsigned pk2(float lo, float hi) { return f2bf(lo) | (f2bf(hi) << 16); }
__device__ __forceinline__ float bflo(unsigned w) { return __builtin_bit_cast(float, w << 16); }
__device__ __forceinline__ float bfhi(unsigned w) { return __builtin_bit_cast(float, w & 0xffff0000u); }
__device__ __forceinline__ float wave_sum(float v) {
#pragma unroll
    for (int o = 1; o < 64; o <<= 1) v += __shfl_xor(v, o);
    return v;
}
__device__ __forceinline__ int crow(int r, int hi) { return (r & 3) + 8 * (r >> 2) + 4 * hi; }

struct Args {
    const float *x_p, *x_s, *c_p, *c_s, *ada_w, *ada_b, *norm_g, *final_g, *w1, *w3, *w2, *even_w_in, *rpb, *pool_w, *pool_scale, *even_w_out,
                *odd_w_in, *sink, *conv_w, *conv_b, *odd_w_out;
    float* out; unsigned char* ws;
};

template <class RowMap>
__device__ __forceinline__ void p0_transpose_item(const float* W, int K, int N, bf16* WT, LAS float* scr, int item, int lane, RowMap rowmap) {
    const int nblk = N / 32, kb = item / nblk, nb = item % nblk, k0 = 64 * kb, n0 = 32 * nb;
#pragma unroll 8
    for (int i = 0; i < 32; ++i) { const int kk = 2 * i + (lane >> 5); scr[kk * 33 + (lane & 31)] = W[(size_t)(k0 + kk) * N + n0 + (lane & 31)]; }
    LDS_WAIT(); asm volatile("" ::: "memory");
    const int c = lane & 7;
#pragma unroll
    for (int j = 0; j < 4; ++j) { const int n = (lane >> 3) + 8 * j; const LAS float* s = scr + (8 * c) * 33 + n;
        v4u o; o.x = pk2(s[0 * 33], s[1 * 33]); o.y = pk2(s[2 * 33], s[3 * 33]); o.z = pk2(s[4 * 33], s[5 * 33]); o.w = pk2(s[6 * 33], s[7 * 33]);
        *(v4u*)(WT + (size_t)rowmap(n0 + n) * K + k0 + 8 * c) = o; }
    LDS_WAIT(); asm volatile("" ::: "memory");
}
struct MapId { __device__ __forceinline__ int operator()(int n) const { return n; } };
struct MapRope { __device__ __forceinline__ int operator()(int n) const { if (n >= 640) return n; const int d = n & 63; return (n & ~63) + ((d & 31) << 1) + (d >> 5); } };
struct MapW1 { __device__ __forceinline__ int operator()(int n) const { return ((n >> 7) << 8) + (n & 127); } };
struct MapW3 { __device__ __forceinline__ int operator()(int n) const { return ((n >> 7) << 8) + 128 + (n & 127); } };

__device__ __forceinline__ int batch_of(int row) { return row < TP ? (row >> 12) : 4 + ((row - TP) >> 14); }

__device__ __forceinline__ void norm_row(const float* xrow, const float* gam, const float* sh, const float* sc, bf16* orow, int lane) {
    const f32x4* xr = (const f32x4*)xrow + lane;
    f32x4 v[4]; float s = 0.f;
#pragma unroll
    for (int j = 0; j < 4; ++j) { v[j] = xr[64 * j]; s += (v[j].x * v[j].x + v[j].y * v[j].y) + (v[j].z * v[j].z + v[j].w * v[j].w); }
    const float rstd = 1.f / sqrtf(wave_sum(s) * (1.f / D) + EPS);
    unsigned long long* o8 = (unsigned long long*)orow + lane;
#pragma unroll
    for (int j = 0; j < 4; ++j) { const f32x4 g = ((const f32x4*)gam)[lane + 64 * j], a = ((const f32x4*)sc)[lane + 64 * j], b = ((const f32x4*)sh)[lane + 64 * j];
        const f32x4 y = (v[j] * rstd) * g * (a + 1.0f) + b;
        o8[64 * j] = (unsigned long long)pk2(y.x, y.y) | ((unsigned long long)pk2(y.z, y.w) << 32); }
}
__device__ __forceinline__ void norm_phase(const Args& A, const float* srcA, const float* srcB, int layer, int which, int gw, int NGW, int lane) {
    const float* mod = (const float*)(A.ws + WS_MOD) + (size_t)layer * NB * 6144 + which * 3072;
    const float* gam = A.norm_g + (layer * 2 + which) * D;
    bf16* H = (bf16*)(A.ws + WS_HA);
    for (int m = gw; m < T; m += NGW) {
        const int b = batch_of(m); const float* xrow = m < TP ? srcA + (size_t)m * D : srcB + (size_t)(m - TP) * D;
        norm_row(xrow, gam, mod + (size_t)b * 6144, mod + (size_t)b * 6144 + 1024, H + (size_t)m * D, lane);
    }
}

#define MFMA32(a, b, c) __builtin_amdgcn_mfma_f32_32x32x16_bf16((a), (b), (c), 0, 0, 0)
template <class SF>
__device__ __forceinline__ void flash_tile(const bf16* Kp, const bf16* Vp, int ldz, LAS unsigned char* vt, const bf16x8 (&qf)[4], float& m, float& l, f32x16 (&o)[2], int lane, const SF& sf) {
    const int r32 = lane & 31, hi = lane >> 5;
    bf16x8 kf[4];
#pragma unroll
    for (int ds = 0; ds < 4; ++ds) kf[ds] = *(const bf16x8*)(Kp + (size_t)r32 * ldz + 16 * ds + 8 * hi);
    v4u vld[4];
#pragma unroll
    for (int i = 0; i < 4; ++i) vld[i] = *(const v4u*)(Vp + (size_t)((lane >> 3) + 8 * i) * ldz + (lane & 7) * 8);
    f32x16 p = {};
#pragma unroll
    for (int ds = 0; ds < 4; ++ds) p = MFMA32(kf[ds], qf[ds], p);
#pragma unroll
    for (int i = 0; i < 4; ++i) *(LAS v4u*)(vt + ((lane >> 3) + 8 * i) * 128 + (lane & 7) * 16) = vld[i];
    float mx = -INFINITY;
#pragma unroll
    for (int r = 0; r < 16; ++r) { p[r] = sf(p[r], r); mx = fmaxf(mx, p[r]); }
    mx = fmaxf(mx, __shfl_xor(mx, 32));
    const float mnew = fmaxf(m, mx), alpha = __builtin_amdgcn_exp2f(m - mnew);
    float rs = 0.f;
#pragma unroll
    for (int r = 0; r < 16; ++r) { p[r] = __builtin_amdgcn_exp2f(p[r] - mnew); rs += p[r]; }
    l = l * alpha + rs; m = mnew;
#pragma unroll
    for (int r = 0; r < 16; ++r) { o[0][r] *= alpha; o[1][r] *= alpha; }
    bf16x8 pb[2];
#pragma unroll
    for (int s = 0; s < 2; ++s) { v4u w; w.x = pk2(p[8 * s], p[8 * s + 1]); w.y = pk2(p[8 * s + 2], p[8 * s + 3]); w.z = pk2(p[8 * s + 4], p[8 * s + 5]); w.w = pk2(p[8 * s + 6], p[8 * s + 7]); pb[s] = __builtin_bit_cast(bf16x8, w); }
    LDS_WAIT();
    const int i16 = lane & 15, q4 = i16 >> 2, p4 = i16 & 3, blk = (lane >> 4) & 1;
#pragma unroll
    for (int dh = 0; dh < 2; ++dh)
#pragma unroll
        for (int s = 0; s < 2; ++s) {
            const LAS unsigned char* a0 = vt + (16 * s + 4 * hi + q4) * 128 + (32 * dh + 16 * blk) * 2 + 8 * p4;
            const s16x4 lo = __builtin_bit_cast(s16x4, __builtin_amdgcn_ds_read_tr16_b64_v4i16((LAS s16x4*)a0));
            const s16x4 hh = __builtin_bit_cast(s16x4, __builtin_amdgcn_ds_read_tr16_b64_v4i16((LAS s16x4*)(a0 + 8 * 128)));
            const bf16x8 vf = __builtin_shufflevector(lo, hh, 0, 1, 2, 3, 4, 5, 6, 7);
            o[dh] = MFMA32(vf, pb[s], o[dh]);
        }
    LDS_WAIT();
}
__device__ __forceinline__ void flash_store(bf16* orow, const f32x16 (&o)[2], float l, int lane) {
    const int hi = lane >> 5; const float inv = 1.0f / (l + __shfl_xor(l, 32));
#pragma unroll
    for (int dh = 0; dh < 2; ++dh)
#pragma unroll
        for (int g = 0; g < 4; ++g) { v2u w; w.x = pk2(o[dh][4 * g] * inv, o[dh][4 * g + 1] * inv); w.y = pk2(o[dh][4 * g + 2] * inv, o[dh][4 * g + 3] * inv);
            *(v2u*)(orow + 32 * dh + 8 * g + 4 * hi) = w; }
}

__device__ __forceinline__ void p0_phase(const Args& A, LAS unsigned char* lds, int tid, int lane, int wave, int G) {
    float* mod = (float*)(A.ws + WS_MOD);
    {
        LAS float* cact = (LAS float*)lds;
        LAS float* part = (LAS float*)(lds + 24576);
        for (int i = tid; i < NB * D; i += NWAVES * 64) { const int b = i >> 10, k = i & 1023; const float c = b < 4 ? A.c_p[b * D + k] : A.c_s[(b - 4) * D + k]; cact[i] = c / (1.0f + __expf(-c)); }
        __syncthreads();
        for (int cb = blockIdx.x; cb < 2 * 6144 / 64; cb += G) {
            const int layer = cb / 96, j = (cb % 96) * 64 + lane; const float* w = A.ada_w + (size_t)layer * D * 6144 + j;
            float acc[NB] = {0.f, 0.f, 0.f, 0.f, 0.f, 0.f};
            const int k0 = wave * 128;
#pragma unroll 16
            for (int k = 0; k < 128; ++k) { const float wv = w[(size_t)(k0 + k) * 6144];
#pragma unroll
                for (int b = 0; b < NB; ++b) acc[b] += cact[b * D + k0 + k] * wv; }
#pragma unroll
            for (int b = 0; b < NB; ++b) part[(wave * NB + b) * 64 + lane] = acc[b];
            __syncthreads();
            if (wave < NB) { float s = A.ada_b[layer * 6144 + j];
#pragma unroll
                for (int w8 = 0; w8 < NWAVES; ++w8) s += part[(w8 * NB + wave) * 64 + lane];
                mod[((size_t)layer * NB + wave) * 6144 + j] = s; }
            __syncthreads();
        }
    }
    const int gw = blockIdx.x * NWAVES + wave, NGW = G * NWAVES;
    {
        float* cosT = (float*)(A.ws + WS_COS); float* sinT = (float*)(A.ws + WS_SIN);
        for (int i = blockIdx.x * NWAVES * 64 + tid; i < 16384 * 32; i += G * NWAVES * 64) {
            const int pos = i >> 5, k = i & 31; const float inv = 1.0f / powf(10000.0f, (float)(2 * k) / 64.0f); const float ang = (float)pos * inv;
            double s, c; sincos((double)ang, &s, &c); cosT[i] = (float)c; sinT[i] = (float)s; }
    }
    {
        LAS float* scr = (LAS float*)(lds + 65536 + wave * 8704);
        constexpr int I_WINE = 16 * 64, I_WO = 16 * 32, I_WINO = 16 * 72, I_W1 = 16 * 88, I_W2 = 44 * 32, I_PW = 2 * 4;
        constexpr int NITEMS = I_WINE + 2 * I_WO + I_WINO + 4 * I_W1 + 2 * I_W2 + 4 * I_PW;
        bf16* ws16 = (bf16*)A.ws;
        for (int it = gw; it < NITEMS; it += NGW) {
            int r = it;
            if (r < I_WINE) { p0_transpose_item(A.even_w_in, D, EVEN_IN, (bf16*)(A.ws + WS_WINE), scr, r, lane, MapId()); continue; } r -= I_WINE;
            if (r < I_WO) { p0_transpose_item(A.even_w_out, D, D, (bf16*)(A.ws + WS_WOE), scr, r, lane, MapId()); continue; } r -= I_WO;
            if (r < I_WO) { p0_transpose_item(A.odd_w_out, D, D, (bf16*)(A.ws + WS_WOO), scr, r, lane, MapId()); continue; } r -= I_WO;
            if (r < I_WINO) { p0_transpose_item(A.odd_w_in, D, ODD_IN, (bf16*)(A.ws + WS_WINO), scr, r, lane, MapRope()); continue; } r -= I_WINO;
            if (r < 2 * I_W1) { const int l = r / I_W1; p0_transpose_item(A.w1 + (size_t)l * D * DFF, D, DFF, (bf16*)(A.ws + WS_W13) + (size_t)l * 5632 * D, scr, r % I_W1, lane, MapW1()); continue; } r -= 2 * I_W1;
            if (r < 2 * I_W1) { const int l = r / I_W1; p0_transpose_item(A.w3 + (size_t)l * D * DFF, D, DFF, (bf16*)(A.ws + WS_W13) + (size_t)l * 5632 * D, scr, r % I_W1, lane, MapW3()); continue; } r -= 2 * I_W1;
            if (r < 2 * I_W2) { const int l = r / I_W2; p0_transpose_item(A.w2 + (size_t)l * DFF * D, DFF, D, (bf16*)(A.ws + WS_W2) + (size_t)l * D * DFF, scr, r % I_W2, lane, MapId()); continue; } r -= 2 * I_W2;
            { const int g = r / I_PW; p0_transpose_item(A.pool_w + (size_t)g * 128 * 128, 128, 128, (bf16*)(A.ws + WS_PW) + (size_t)g * 128 * 128, scr, r % I_PW, lane, MapId()); }
        }
        (void)ws16;
    }
}

struct SfNA { const LAS float* rp; int cq, cs, kc0, hi;
    __device__ __forceinline__ float operator()(float p, int r) const { const int kc = kc0 + crow(r, hi); const bool ok = (kc >= cs) && (kc < cs + 16); int dc = kc - cq + 15; dc = dc < 0 ? 0 : (dc > 30 ? 30 : dc);
        return ok ? (p * 0.125f + rp[dc]) * LOG2E : -INFINITY; } };
__device__ __forceinline__ void even_mixer_phase(const Args& A, LAS unsigned char* lds, int tid, int lane, int wave, int G) {
    const bf16* Z = (const bf16*)(A.ws + WS_ZR); bf16* AO = (bf16*)(A.ws + WS_HA);
    LAS float* rpb = (LAS float*)lds;
    for (int i = tid; i < 8 * 15 * 31; i += NWAVES * 64) rpb[i] = A.rpb[i];
    __syncthreads();
    LAS unsigned char* vt = lds + 16384 + wave * 4096;
    const int gw = blockIdx.x * NWAVES + wave, NGW = G * NWAVES; const int r32 = lane & 31, hi = lane >> 5;
    constexpr int NTT = T / 32;
#pragma unroll 1
    for (int it = gw; it < NTT * 8; it += NGW) {
        const int hh = it / NTT, tt = it % NTT, t0 = tt * 32;
        const int L = t0 < TP ? LP : LS, rows = L / 64, pos0 = t0 & (L - 1), sb = t0 - pos0;
        const int r = pos0 >> 6, cq = (pos0 & 63) + r32; int cs = cq - 8; cs = cs < 0 ? 0 : (cs > 48 ? 48 : cs);
        int rs = r - 4; rs = rs < 0 ? 0 : (rs > rows - 8 ? rows - 8 : rs);
        bf16x8 qf[4];
#pragma unroll
        for (int ds = 0; ds < 4; ++ds) qf[ds] = *(const bf16x8*)(Z + (size_t)(t0 + r32) * EVEN_IN + hh * 64 + 16 * ds + 8 * hi);
        float m = -1e30f, l = 0.f; f32x16 o[2]; o[0] = f32x16{}; o[1] = f32x16{};
#pragma unroll 1
        for (int i = 0; i < 8; ++i) { const int kr = rs + i, dr = kr - r + 7;
#pragma unroll 1
            for (int ct = 0; ct < 2; ++ct) { const size_t tk0 = (size_t)sb + kr * 64 + ct * 32;
                SfNA sf{rpb + (hh * 15 + dr) * 31, cq, cs, ct * 32, hi};
                flash_tile(Z + tk0 * EVEN_IN + 512 + hh * 64, Z + tk0 * EVEN_IN + 1024 + hh * 64, EVEN_IN, vt, qf, m, l, o, lane, sf); } }
        flash_store(AO + (size_t)(t0 + r32) * D + hh * 64, o, l, lane);
    }
    const bf16* PW = (const bf16*)(A.ws + WS_PW);
#pragma unroll 1
    for (int it = gw; it < NTT * 4; it += NGW) {
        const int g = it / NTT, tt = it % NTT, t0 = tt * 32, w = 2 << g, half = w >> 1;
        const int L = t0 < TP ? LP : LS, pos0 = t0 & (L - 1), sb = t0 - pos0, pos = pos0 + r32;
        const int lo = pos - half < 0 ? 0 : pos - half, hiw = pos + half > L ? L : pos + half; const float rc = 1.0f / (float)(hiw - lo);
        const bf16* ub = Z + 1536 + g * 128 + 8 * hi;
        bf16x8 bfr[8];
#pragma unroll
        for (int ks = 0; ks < 8; ++ks) {
            float sm[8] = {0.f, 0.f, 0.f, 0.f, 0.f, 0.f, 0.f, 0.f};
            for (int j = 0; j < w; ++j) { const int tp = pos - half + j; if (tp >= 0 && tp < L) { const v4u v = *(const v4u*)(ub + (size_t)(sb + tp) * EVEN_IN + 16 * ks);
                sm[0] += bflo(v.x); sm[1] += bfhi(v.x); sm[2] += bflo(v.y); sm[3] += bfhi(v.y); sm[4] += bflo(v.z); sm[5] += bfhi(v.z); sm[6] += bflo(v.w); sm[7] += bfhi(v.w); } }
            const v4u u = *(const v4u*)(ub + (size_t)(sb + pos) * EVEN_IN + 16 * ks);
            v4u mx; mx.x = pk2(sm[0] * rc - bflo(u.x), sm[1] * rc - bfhi(u.x)); mx.y = pk2(sm[2] * rc - bflo(u.y), sm[3] * rc - bfhi(u.y));
            mx.z = pk2(sm[4] * rc - bflo(u.z), sm[5] * rc - bfhi(u.z)); mx.w = pk2(sm[6] * rc - bflo(u.w), sm[7] * rc - bfhi(u.w));
            bfr[ks] = __builtin_bit_cast(bf16x8, mx);
        }
#pragma unroll
        for (int et = 0; et < 4; ++et) { f32x16 acc = {};
#pragma unroll
            for (int ks = 0; ks < 8; ++ks) { const bf16x8 af = *(const bf16x8*)(PW + (size_t)g * 16384 + (size_t)(32 * et + r32) * 128 + 16 * ks + 8 * hi); acc = MFMA32(af, bfr[ks], acc); }
            bf16* orow = AO + (size_t)(t0 + r32) * D + 512 + g * 128 + 32 * et; const float* scl = A.pool_scale + g * 128 + 32 * et;
#pragma unroll
            for (int q = 0; q < 4; ++q) { const f32x4 sv = *(const f32x4*)(scl + 8 * q + 4 * hi); v2u wv; wv.x = pk2(acc[4 * q] * sv.x, acc[4 * q + 1] * sv.y); wv.y = pk2(acc[4 * q + 2] * sv.z, acc[4 * q + 3] * sv.w);
                *(v2u*)(orow + 8 * q + 4 * hi) = wv; } }
    }
}

struct SfSWA { int mode, qi, hi;
    __device__ __forceinline__ float operator()(float p, int r) const { const int ki = crow(r, hi); const bool ok = mode == 0 || (mode < 0 ? ki >= qi : ki <= qi); return ok ? p * (0.125f * LOG2E) : -INFINITY; } };
__device__ __forceinline__ void odd_mixer_phase(const Args& A, LAS unsigned char* lds, int tid, int lane, int wave, int G) {
    const bf16* Z = (const bf16*)(A.ws + WS_ZR); bf16* AO = (bf16*)(A.ws + WS_HA);
    LAS unsigned char* vt = lds + 16384 + wave * 4096;
    const int gw = blockIdx.x * NWAVES + wave, NGW = G * NWAVES; const int r32 = lane & 31, hi = lane >> 5;
    constexpr int NTT = T / 32;
#pragma unroll 1
    for (int it = gw; it < NTT * 8; it += NGW) {
        const int hq = it / NTT, tt = it % NTT, t0 = tt * 32, kvh = hq >> 2;
        const int L = t0 < TP ? LP : LS, pos0 = t0 & (L - 1), sb = t0 - pos0;
        bf16x8 qf[4];
#pragma unroll
        for (int ds = 0; ds < 4; ++ds) qf[ds] = *(const bf16x8*)(Z + (size_t)(t0 + r32) * ODD_IN + hq * 64 + 16 * ds + 8 * hi);
        float m = A.sink[hq] * LOG2E, l = hi == 0 ? 1.0f : 0.0f; f32x16 o[2]; o[0] = f32x16{}; o[1] = f32x16{};
#pragma unroll 1
        for (int jt = -4; jt <= 4; ++jt) { const int kp0 = pos0 + 32 * jt; if (kp0 < 0 || kp0 >= L) continue;
            const size_t tk0 = (size_t)sb + kp0; SfSWA sf{jt == -4 ? -1 : (jt == 4 ? 1 : 0), r32, hi};
            flash_tile(Z + tk0 * ODD_IN + 512 + kvh * 64, Z + tk0 * ODD_IN + 640 + kvh * 64, ODD_IN, vt, qf, m, l, o, lane, sf); }
        flash_store(AO + (size_t)(t0 + r32) * D + hq * 64, o, l, lane);
    }
    for (size_t i = (size_t)blockIdx.x * NWAVES * 64 + tid; i < (size_t)T * 64; i += (size_t)G * NWAVES * 64) {
        const int t = (int)(i >> 6), c = (int)(i & 63) * 8; const int L = t < TP ? LP : LS, pos = t & (L - 1);
        const bf16* zr = Z + (size_t)t * ODD_IN; const v4u bg = *(const v4u*)(zr + 768 + c);
        float cv[8]; { const f32x4 b0 = *(const f32x4*)(A.conv_b + c), b1 = *(const f32x4*)(A.conv_b + c + 4); cv[0] = b0.x; cv[1] = b0.y; cv[2] = b0.z; cv[3] = b0.w; cv[4] = b1.x; cv[5] = b1.y; cv[6] = b1.z; cv[7] = b1.w; }
#pragma unroll
        for (int j = 0; j < 3; ++j) { const int tp = pos + j - 1; if (tp < 0 || tp >= L) continue;
            const bf16* zp = zr + (ptrdiff_t)(j - 1) * ODD_IN; const v4u cgv = *(const v4u*)(zp + 1280 + c), xv = *(const v4u*)(zp + 1792 + c);
            const f32x4 w0 = *(const f32x4*)(A.conv_w + j * 512 + c), w1 = *(const f32x4*)(A.conv_w + j * 512 + c + 4);
            cv[0] += w0.x * (bflo(cgv.x) * bflo(xv.x)); cv[1] += w0.y * (bfhi(cgv.x) * bfhi(xv.x)); cv[2] += w0.z * (bflo(cgv.y) * bflo(xv.y)); cv[3] += w0.w * (bfhi(cgv.y) * bfhi(xv.y));
            cv[4] += w1.x * (bflo(cgv.z) * bflo(xv.z)); cv[5] += w1.y * (bfhi(cgv.z) * bfhi(xv.z)); cv[6] += w1.z * (bflo(cgv.w) * bflo(xv.w)); cv[7] += w1.w * (bfhi(cgv.w) * bfhi(xv.w)); }
        v4u o; o.x = pk2(bflo(bg.x) * cv[0], bfhi(bg.x) * cv[1]); o.y = pk2(bflo(bg.y) * cv[2], bfhi(bg.y) * cv[3]); o.z = pk2(bflo(bg.z) * cv[4], bfhi(bg.z) * cv[5]); o.w = pk2(bflo(bg.w) * cv[6], bfhi(bg.w) * cv[7]);
        *(v4u*)(AO + (size_t)t * D + 512 + c) = o;
    }
}

__global__ void __launch_bounds__(NWAVES * 64, 2) hybrid_fwd(Args A) {
    extern __shared__ __attribute__((aligned(16))) unsigned char lds_raw[];
    LAS unsigned char* lds = (LAS unsigned char*)lds_raw;
    cg::grid_group grid = cg::this_grid();
    int tid = threadIdx.x, lane = tid & 63, wave = __builtin_amdgcn_readfirstlane(tid >> 6); const int G = gridDim.x;
    int gw = blockIdx.x * NWAVES + wave; const int NGW = G * NWAVES;
    float* const X = A.out; const float* const mod = (const float*)(A.ws + WS_MOD);
    bf16* const HA = (bf16*)(A.ws + WS_HA); bf16* const ZR = (bf16*)(A.ws + WS_ZR);
    const float* cosT = (const float*)(A.ws + WS_COS); const float* sinT = (const float*)(A.ws + WS_SIN);

#define RELAUNDER() do { int t_ = threadIdx.x; asm volatile("" : "+v"(t_)); tid = t_; lane = tid & 63; wave = __builtin_amdgcn_readfirstlane(tid >> 6); gw = blockIdx.x * NWAVES + wave; } while (0)
    p0_phase(A, lds, tid, lane, wave, G);
    grid.sync();
#pragma unroll 1
    for (int layer = 0; layer < 2; ++layer) {
        const float* srcA = layer == 0 ? A.x_p : X; const float* srcB = layer == 0 ? A.x_s : X + (size_t)TP * D;
        RELAUNDER(); norm_phase(A, srcA, srcB, layer, 0, gw, NGW, lane);
        grid.sync();
        {
            const int N = layer == 0 ? EVEN_IN : ODD_IN;
            pg8::Gemm g{HA, (const bf16*)(A.ws + (layer == 0 ? WS_WINE : WS_WINO)), T, N, D}; pg8::StaticOrder S; S.init(T, N, G, (int)blockIdx.x);
            pg8::EpiBf16R E{ZR, N, layer == 0 ? 0 : 640, cosT, sinT};
            pg8::gemm_phase<pg8::EpiBf16R, pg8::StaticOrder, true, true>(lds, g, S, E);
        }
        grid.sync();
        RELAUNDER();
        if (layer == 0) even_mixer_phase(A, lds, tid, lane, wave, G); else odd_mixer_phase(A, lds, tid, lane, wave, G);
        grid.sync();
        {
            pg8::Gemm g{HA, (const bf16*)(A.ws + (layer == 0 ? WS_WOE : WS_WOO)), T, D, D}; pg8::StaticOrder S; S.init(T, D, G, (int)blockIdx.x);
            pg8::EpiRes E{srcA, srcB, X, mod + (size_t)layer * NB * 6144 + 2048};
            pg8::gemm_phase<pg8::EpiRes, pg8::StaticOrder, true, true>(lds, g, S, E);
        }
        grid.sync();
        RELAUNDER(); norm_phase(A, X, X + (size_t)TP * D, layer, 1, gw, NGW, lane);
        grid.sync();
        {
            pg8::Gemm g{HA, (const bf16*)(A.ws + WS_W13) + (size_t)layer * 5632 * D, T, 5632, D}; pg8::StaticOrder S; S.init(T, 5632, G, (int)blockIdx.x);
            pg8::EpiSwiGLU E{ZR, DFF};
            pg8::gemm_phase<pg8::EpiSwiGLU, pg8::StaticOrder, true, true>(lds, g, S, E);
        }
        grid.sync();
        {
            pg8::Gemm g{ZR, (const bf16*)(A.ws + WS_W2) + (size_t)layer * D * DFF, T, D, DFF}; pg8::StaticOrder S; S.init(T, D, G, (int)blockIdx.x);
            pg8::EpiRes E{X, X + (size_t)TP * D, X, mod + (size_t)layer * NB * 6144 + 5120};
            pg8::gemm_phase<pg8::EpiRes, pg8::StaticOrder, true, true>(lds, g, S, E);
        }
        grid.sync();
    }
    RELAUNDER();
    for (int mrow = gw; mrow < T; mrow += NGW) {
        f32x4* xr = (f32x4*)(X + (size_t)mrow * D) + lane; f32x4 v[4]; float s = 0.f;
#pragma unroll
        for (int j = 0; j < 4; ++j) { v[j] = xr[64 * j]; s += (v[j].x * v[j].x + v[j].y * v[j].y) + (v[j].z * v[j].z + v[j].w * v[j].w); }
        const float rstd = 1.f / sqrtf(wave_sum(s) * (1.f / D) + EPS);
#pragma unroll
        for (int j = 0; j < 4; ++j) xr[64 * j] = (v[j] * rstd) * ((const f32x4*)A.final_g)[lane + 64 * j];
    }
}

extern "C" void kernel_launch(void* const* d_in, const int* in_sizes, int n_in, void* d_out, int out_size, void* d_ws, size_t ws_size, hipStream_t stream) {
    static int grid = 0;
    if (grid == 0) {
        if (n_in != 21 || out_size != T * D || ws_size < WS_END) { fprintf(stderr, "kernel_launch: unexpected shapes (n_in %d out %d ws %zu)\n", n_in, out_size, ws_size); grid = -1; return; }
        int dev = 0, cus = 0, per_cu = 0;
        hipGetDevice(&dev); hipDeviceGetAttribute(&cus, hipDeviceAttributeMultiprocessorCount, dev);
        hipFuncSetAttribute((const void*)hybrid_fwd, hipFuncAttributeMaxDynamicSharedMemorySize, LDS_BYTES);
        if (hipOccupancyMaxActiveBlocksPerMultiprocessor(&per_cu, (const void*)hybrid_fwd, NWAVES * 64, LDS_BYTES) != hipSuccess || per_cu < 1) per_cu = 1;
        (void)hipGetLastError();
        grid = cus * per_cu;
    }
    if (grid < 0) return;
    Args a{};
    const float** p = (const float**)&a;
    for (int i = 0; i < 21; ++i) p[i] = (const float*)d_in[i];
    a.out = (float*)d_out; a.ws = (unsigned char*)d_ws;
    void* args[] = {&a};
    hipError_t e = hipLaunchCooperativeKernel((const void*)hybrid_fwd, dim3(grid), dim3(NWAVES * 64), args, LDS_BYTES, stream);
    if (e != hipSuccess) fprintf(stderr, "cooperative launch failed: %s (grid %d)\n", hipGetErrorString(e), grid);
}
```

```cpp
#include <hip/hip_runtime.h>
#include <hip/hip_cooperative_groups.h>
#include <cstdio>
#include <cstdint>
namespace cg = cooperative_groups;
namespace pg8 {
#define PG8_LAS __attribute__((address_space(3)))
typedef unsigned short bf16_t;
typedef short bf16x8 __attribute__((ext_vector_type(8)));
typedef float f32x4 __attribute__((ext_vector_type(4)));
typedef unsigned u32x4 __attribute__((ext_vector_type(4)));
constexpr int BM = 256, BK = 64, HALF = 128, HTB = HALF * BK * 2  , STAGE_BYTES = 8 * HTB, NXCD = 8, WGM = 8;

__host__ __device__ __forceinline__ int lds_byte(int r, int c) { const int st = (r >> 4) * 2 + (c >> 5), rr = r & 15, cc = c & 31, ob = rr * 64 + cc * 2; return st * 1024 + (ob ^ (((ob >> 9) & 1) << 5)); }
__host__ __device__ __forceinline__ void stage_rc(int b, int& R, int& C) { const int st = b / 1024, sb = b % 1024, swz = sb ^ (((sb >> 9) & 1) << 5); R = (st >> 1) * 16 + swz / 64; C = (st & 1) * 32 + (swz % 64) / 2; }
__host__ __device__ __forceinline__ int perm32(int rho) { const int n = rho >> 4, i = rho & 15; return 8 * (i >> 2) + 4 * n + (i & 3); }

struct Unit { int pm, pn; };
struct Gemm { const bf16_t* A; const bf16_t* Bt; int M, N, K; };

struct StaticOrder {
    int nM, nN, nwg, G, c;
    __host__ __device__ void init(int M, int N, int G_, int c_) { nM = M / BM; nN = N / BM; nwg = nM * nN; G = G_; c = c_; }
    __host__ __device__ bool next(int i, Unit& u) const {
        const long L = (long)i * G + c; if (L >= nwg) return false;
        int wgid = (int)L; { const int q = nwg / NXCD, r = nwg % NXCD, xcd = wgid % NXCD, off = wgid / NXCD; wgid = (xcd < r ? xcd * (q + 1) : r * (q + 1) + (xcd - r) * q) + off; }
        const int nig = WGM * nN, gid = wgid / nig, fm = gid * WGM, gsz = (nM - fm) < WGM ? (nM - fm) : WGM;
        u.pm = fm + ((wgid % nig) % gsz); u.pn = (wgid % nig) / gsz; return true;
    }
    __device__ __forceinline__ void a_ready(const Unit&) const {}
    __device__ __forceinline__ void done(const Unit&) const {}
};

typedef float f32x2_t __attribute__((ext_vector_type(2))); typedef __bf16 bf16x2_t __attribute__((ext_vector_type(2)));
__device__ __forceinline__ unsigned cvt_pk_bf16(float lo, float hi) { f32x2_t v = {lo, hi}; bf16x2_t b = __builtin_convertvector(v, bf16x2_t); return __builtin_bit_cast(unsigned, b); }

struct EpiBf16R {
    static constexpr bool PERM = true, AFTER_DRAIN = false;
    bf16_t* O; int ldc; int rope_cols; const float* cosT; const float* sinT;
    __device__ __forceinline__ void operator()(const f32x4 (&acc)[2][2][4][2], const Unit& u, int wr, int wc, int fr, int fq) const {
        const int row0 = u.pm * BM + wr * 64 + fr; const int col0 = u.pn * BM + wc * 32 + 8 * fq;
#pragma unroll
        for (int ai = 0; ai < 2; ++ai)
#pragma unroll
            for (int m = 0; m < 4; ++m) { const int row = row0 + ai * HALF + m * 16; bf16_t* rowp = O + (size_t)row * ldc + col0; const int pos = row & 16383 & (row < 16384 ? 4095 : 16383);
#pragma unroll
                for (int bj = 0; bj < 2; ++bj) { f32x4 v0 = acc[ai][bj][m][0], v1 = acc[ai][bj][m][1];
                    const int c = col0 + bj * HALF;
                    if (c < rope_cols) { const int i0 = (c & 63) >> 1; const f32x4 cs = *(const f32x4*)(cosT + (size_t)pos * 32 + i0), sn = *(const f32x4*)(sinT + (size_t)pos * 32 + i0);
                        f32x4 w0, w1;
                        w0[0] = v0[0] * cs[0] - v0[1] * sn[0]; w0[1] = v0[0] * sn[0] + v0[1] * cs[0];
                        w0[2] = v0[2] * cs[1] - v0[3] * sn[1]; w0[3] = v0[2] * sn[1] + v0[3] * cs[1];
                        w1[0] = v1[0] * cs[2] - v1[1] * sn[2]; w1[1] = v1[0] * sn[2] + v1[1] * cs[2];
                        w1[2] = v1[2] * cs[3] - v1[3] * sn[3]; w1[3] = v1[2] * sn[3] + v1[3] * cs[3];
                        v0 = w0; v1 = w1; }
                    u32x4 w; w.x = cvt_pk_bf16(v0[0], v0[1]); w.y = cvt_pk_bf16(v0[2], v0[3]); w.z = cvt_pk_bf16(v1[0], v1[1]); w.w = cvt_pk_bf16(v1[2], v1[3]);
                    *(u32x4*)(rowp + bj * HALF) = w; } }
    }
};
__device__ __forceinline__ float silu_f(float x) { return x * __builtin_amdgcn_rcpf(1.0f + __builtin_amdgcn_exp2f(-1.4426950408889634f * x)); }
struct EpiSwiGLU {
    static constexpr bool PERM = true, AFTER_DRAIN = false;
    bf16_t* O; int ldc;
    __device__ __forceinline__ void operator()(const f32x4 (&acc)[2][2][4][2], const Unit& u, int wr, int wc, int fr, int fq) const {
        const int row0 = u.pm * BM + wr * 64 + fr; const int col0 = u.pn * HALF + wc * 32 + 8 * fq;
#pragma unroll
        for (int ai = 0; ai < 2; ++ai)
#pragma unroll
            for (int m = 0; m < 4; ++m) { bf16_t* rowp = O + (size_t)(row0 + ai * HALF + m * 16) * ldc + col0;
                const f32x4 g0 = acc[ai][0][m][0], g1 = acc[ai][0][m][1], u0 = acc[ai][1][m][0], u1 = acc[ai][1][m][1];
                u32x4 w; w.x = cvt_pk_bf16(silu_f(g0[0]) * u0[0], silu_f(g0[1]) * u0[1]); w.y = cvt_pk_bf16(silu_f(g0[2]) * u0[2], silu_f(g0[3]) * u0[3]);
                w.z = cvt_pk_bf16(silu_f(g1[0]) * u1[0], silu_f(g1[1]) * u1[1]); w.w = cvt_pk_bf16(silu_f(g1[2]) * u1[2], silu_f(g1[3]) * u1[3]);
                *(u32x4*)rowp = w; }
    }
};
struct EpiRes {
    static constexpr bool PERM = false, AFTER_DRAIN = false;
    const float* srcA; const float* srcB; float* out; const float* gate;
    __device__ __forceinline__ void operator()(const f32x4 (&acc)[2][2][4][2], const Unit& u, int wr, int wc, int fr, int fq) const {
        const int rbase = u.pm * BM; const int row0 = rbase + wr * 64 + fr, col0 = u.pn * BM + wc * 32 + 4 * fq;
        const int b = rbase < 16384 ? (rbase >> 12) : 4 + ((rbase - 16384) >> 14);
        const float* src = rbase < 16384 ? srcA : srcB - (size_t)16384 * 1024;
        const float* g = gate + (size_t)b * 6144 + col0;
        f32x4 gv[2][2];
#pragma unroll
        for (int bj = 0; bj < 2; ++bj)
#pragma unroll
            for (int n = 0; n < 2; ++n) gv[bj][n] = *(const f32x4*)(g + bj * HALF + n * 16);
#pragma unroll
        for (int ai = 0; ai < 2; ++ai)
#pragma unroll
            for (int m = 0; m < 4; ++m) { const size_t off = (size_t)(row0 + ai * HALF + m * 16) * 1024 + col0;
#pragma unroll
                for (int bj = 0; bj < 2; ++bj)
#pragma unroll
                    for (int n = 0; n < 2; ++n) { const f32x4 s = *(const f32x4*)(src + off + bj * HALF + n * 16); *(f32x4*)(out + off + bj * HALF + n * 16) = s + gv[bj][n] * acc[ai][bj][m][n]; } }
    }
};

template <class Epi, class Sched, bool ALIGN_EPI = false, bool SP2 = false>
__device__ __forceinline__ void gemm_phase(PG8_LAS unsigned char* lds, const Gemm g, const Sched& S, const Epi& E) {
    int tid_ = threadIdx.x; asm volatile("" : "+v"(tid_));
    const int tid = tid_, wid = __builtin_amdgcn_readfirstlane(tid >> 6), lane = tid & 63, wr = wid >> 2, wc = wid & 3, fr = lane & 15, fq = lane >> 4;
    const int K = g.K, nt = K / BK;
    unsigned voffA[2], voffB[2];
#pragma unroll
    for (int i = 0; i < 2; ++i) { int R, C; stage_rc(tid * 16 + i * 8192, R, C); const int Rb = Epi::PERM ? ((R & ~31) + perm32(R & 31)) : R;
        voffA[i] = (unsigned)(R * K + C) * 2u; voffB[i] = (unsigned)(Rb * K + C) * 2u; }
    const size_t kstep = (size_t)(BK * 2);
    const size_t hstep = (size_t)HALF * K * 2;
    const size_t tstep = 2 * hstep;
    const unsigned ldsw = (unsigned)wid * 1024u;
    const int aoff = lds_byte(wr * 64 + fr, fq * 8), boff = lds_byte(wc * 32 + fr, fq * 8);
#define PG8_SA(b, h) (((b) * 2 + (h)) * HTB)
#define PG8_SB(b, h) ((4 + (b) * 2 + (h)) * HTB)
#define PG8_STAGE(bufoff, gbase, voff) do { _Pragma("unroll") for (int _i = 0; _i < 2; ++_i) \
        __builtin_amdgcn_global_load_lds((const unsigned*)((const char*)(gbase) + (voff)[_i]), (PG8_LAS unsigned*)(lds + (bufoff) + ldsw + _i * 8192), 16, 0, 0); } while (0)
#define PG8_LDA(dst, b, h) do { _Pragma("unroll") for (int m = 0; m < 4; ++m) _Pragma("unroll") for (int k = 0; k < 2; ++k) dst[m][k] = *(const PG8_LAS bf16x8*)(lds + PG8_SA(b, h) + aoff + m * 2048 + k * 1024); } while (0)
#define PG8_LDB(dst, b, h) do { _Pragma("unroll") for (int n = 0; n < 2; ++n) _Pragma("unroll") for (int k = 0; k < 2; ++k) dst[n][k] = *(const PG8_LAS bf16x8*)(lds + PG8_SB(b, h) + boff + n * 2048 + k * 1024); } while (0)
#define PG8_MMA(ai, bj, At, Bt) do { __builtin_amdgcn_s_setprio(1); _Pragma("unroll") for (int m = 0; m < 4; ++m) _Pragma("unroll") for (int n = 0; n < 2; ++n) _Pragma("unroll") for (int k = 0; k < 2; ++k) \
        acc[ai][bj][m][n] = __builtin_amdgcn_mfma_f32_16x16x32_bf16(Bt[n][k], At[m][k], acc[ai][bj][m][n], 0, 0, 0); __builtin_amdgcn_s_setprio(0); } while (0)
#define PG8_WAIT_V(n) asm volatile("s_waitcnt vmcnt(" #n ")" ::: "memory")
#define PG8_WAIT_L(n) asm volatile("s_waitcnt lgkmcnt(" #n ")" ::: "memory")
#define PG8_BAR __builtin_amdgcn_s_barrier()
#define PG8_SCHED __builtin_amdgcn_sched_barrier(0)
    Unit cur, nxt; int ui = 0;
    if (!S.next(0, cur)) return;
    f32x4 acc[2][2][4][2];
#pragma unroll
    for (int a = 0; a < 2; ++a)
#pragma unroll
        for (int b = 0; b < 2; ++b)
#pragma unroll
            for (int m = 0; m < 4; ++m)
#pragma unroll
                for (int n = 0; n < 2; ++n) acc[a][b][m][n] = (f32x4){0.f, 0.f, 0.f, 0.f};
    bf16x8 At[4][2], B0[2][2], B1[2][2];
    const char* cA = (const char*)g.A + (size_t)cur.pm * tstep; const char* cB = (const char*)g.Bt + (size_t)cur.pn * tstep;
    S.a_ready(cur);
    if constexpr (SP2) {
        PG8_STAGE(PG8_SB(0, 0), cB, voffB); PG8_STAGE(PG8_SB(0, 1), cB + hstep, voffB); PG8_STAGE(PG8_SA(0, 0), cA, voffA); PG8_STAGE(PG8_SA(0, 1), cA + hstep, voffA);
        if (wr == 1) PG8_BAR;
        PG8_WAIT_V(2); PG8_BAR;
        PG8_STAGE(PG8_SB(1, 0), cB + kstep, voffB); PG8_STAGE(PG8_SA(1, 0), cA + kstep, voffA); PG8_STAGE(PG8_SB(1, 1), cB + hstep + kstep, voffB);
        PG8_WAIT_V(6); PG8_BAR;
    } else {
        PG8_STAGE(PG8_SB(0, 0), cB, voffB); PG8_STAGE(PG8_SA(0, 0), cA, voffA); PG8_STAGE(PG8_SB(0, 1), cB + hstep, voffB); PG8_STAGE(PG8_SA(0, 1), cA + hstep, voffA);
        if (wr == 1) PG8_BAR;
        PG8_WAIT_V(4); PG8_BAR;
        PG8_STAGE(PG8_SB(1, 0), cB + kstep, voffB); PG8_STAGE(PG8_SA(1, 0), cA + kstep, voffA); PG8_STAGE(PG8_SB(1, 1), cB + hstep + kstep, voffB);
        PG8_WAIT_V(6); PG8_BAR;
    }
    for (;;) {
        const bool has_next = S.next(ui + 1, nxt);
        const char* nA = has_next ? (const char*)g.A + (size_t)nxt.pm * tstep : cA; const char* nB = has_next ? (const char*)g.Bt + (size_t)nxt.pn * tstep : cB;
        for (int t = 0; t < nt; t += 2) {
            const bool last = (t == nt - 2);
            const char* a1 = cA + (size_t)(t + 1) * kstep;
            const char* a2 = last ? nA : cA + (size_t)(t + 2) * kstep; const char* b2 = last ? nB : cB + (size_t)(t + 2) * kstep;
            const char* a3 = a2 + kstep; const char* b3 = b2 + kstep;
            if (last && has_next) S.a_ready(nxt);
            if constexpr (SP2) {
            PG8_LDB(B0, 0, 0); PG8_LDB(B1, 0, 1); PG8_SCHED; PG8_LDA(At, 0, 0); PG8_STAGE(PG8_SA(1, 1), a1 + hstep, voffA);
            PG8_WAIT_V(8); PG8_WAIT_L(0); PG8_BAR; PG8_MMA(0, 0, At, B0); PG8_MMA(0, 1, At, B1); PG8_BAR; PG8_SCHED;
            PG8_LDA(At, 0, 1); PG8_STAGE(PG8_SB(0, 0), b2, voffB); PG8_STAGE(PG8_SB(0, 1), b2 + hstep, voffB); PG8_STAGE(PG8_SA(0, 0), a2, voffA);
            PG8_WAIT_V(8); PG8_WAIT_L(0); PG8_BAR; PG8_MMA(1, 0, At, B0); PG8_MMA(1, 1, At, B1); PG8_BAR; PG8_SCHED;
            PG8_LDB(B0, 1, 0); PG8_LDB(B1, 1, 1); PG8_SCHED; PG8_LDA(At, 1, 0); PG8_STAGE(PG8_SA(0, 1), a2 + hstep, voffA);
            PG8_WAIT_V(8); PG8_WAIT_L(0); PG8_BAR; PG8_MMA(0, 0, At, B0); PG8_MMA(0, 1, At, B1); PG8_BAR; PG8_SCHED;
            PG8_LDA(At, 1, 1); PG8_STAGE(PG8_SB(1, 0), b3, voffB); PG8_STAGE(PG8_SB(1, 1), b3 + hstep, voffB); PG8_STAGE(PG8_SA(1, 0), a3, voffA);
            PG8_WAIT_V(8); PG8_WAIT_L(0); PG8_BAR; PG8_MMA(1, 0, At, B0); PG8_MMA(1, 1, At, B1); PG8_BAR; PG8_SCHED;
            } else {
            PG8_LDB(B0, 0, 0); PG8_SCHED; PG8_LDA(At, 0, 0); PG8_STAGE(PG8_SA(1, 1), a1 + hstep, voffA);
            PG8_WAIT_L(8); PG8_BAR; PG8_WAIT_L(0); PG8_MMA(0, 0, At, B0); PG8_BAR; PG8_SCHED;
            PG8_LDB(B1, 0, 1); PG8_STAGE(PG8_SB(0, 0), b2, voffB);
            PG8_BAR; PG8_WAIT_L(0); PG8_MMA(0, 1, At, B1); PG8_BAR;
            PG8_LDA(At, 0, 1); PG8_STAGE(PG8_SA(0, 0), a2, voffA);
            PG8_BAR; PG8_WAIT_L(0); PG8_MMA(1, 0, At, B0); PG8_BAR; PG8_SCHED;
            PG8_STAGE(PG8_SB(0, 1), b2 + hstep, voffB);
            PG8_WAIT_V(6); PG8_BAR; PG8_MMA(1, 1, At, B1); PG8_BAR;
            PG8_LDB(B0, 1, 0); PG8_SCHED; PG8_LDA(At, 1, 0); PG8_STAGE(PG8_SA(0, 1), a2 + hstep, voffA);
            PG8_WAIT_L(8); PG8_BAR; PG8_WAIT_L(0); PG8_MMA(0, 0, At, B0); PG8_BAR; PG8_SCHED;
            PG8_LDB(B1, 1, 1); PG8_STAGE(PG8_SB(1, 0), b3, voffB);
            PG8_BAR; PG8_WAIT_L(0); PG8_MMA(0, 1, At, B1); PG8_BAR;
            PG8_LDA(At, 1, 1); PG8_STAGE(PG8_SA(1, 0), a3, voffA);
            PG8_BAR; PG8_WAIT_L(0); PG8_MMA(1, 0, At, B0); PG8_BAR; PG8_SCHED;
            PG8_STAGE(PG8_SB(1, 1), b3 + hstep, voffB);
            PG8_WAIT_V(6); PG8_BAR; PG8_MMA(1, 1, At, B1); PG8_BAR;
            }
        }
        if constexpr (ALIGN_EPI) { if (wr == 0) PG8_BAR; }
        if constexpr (!Epi::AFTER_DRAIN) { E(acc, cur, wr, wc, fr, fq); S.done(cur); }
        if (!has_next) break;
#pragma unroll
        for (int a = 0; a < 2; ++a)
#pragma unroll
            for (int b = 0; b < 2; ++b)
#pragma unroll
                for (int m = 0; m < 4; ++m)
#pragma unroll
                    for (int n = 0; n < 2; ++n) acc[a][b][m][n] = (f32x4){0.f, 0.f, 0.f, 0.f};
        cur = nxt; cA = nA; cB = nB; ++ui;
        if constexpr (ALIGN_EPI) { if (wr == 1) PG8_BAR; }
    }
    PG8_WAIT_V(0);
    if constexpr (!ALIGN_EPI) { if (wr == 0) PG8_BAR; }
    PG8_BAR;
    if constexpr (Epi::AFTER_DRAIN) { E.fused(acc, cur, wr, wc, fr, fq, lds, wid, lane); S.done(cur); }
#undef PG8_SA
#undef PG8_SB
#undef PG8_STAGE
#undef PG8_LDA
#undef PG8_LDB
#undef PG8_MMA
#undef PG8_WAIT_V
#undef PG8_WAIT_L
#undef PG8_BAR
#undef PG8_SCHED
}
}

constexpr int D = 1024, TP = 16384, TS = 32768, T = TP + TS, LP = 4096, LS = 16384, NB = 6, DFF = 2816;
constexpr int EVEN_IN = 2048, ODD_IN = 2304;
constexpr float EPS = 1e-6f, LOG2E = 1.4426950408889634f;
constexpr int NWAVES = 8;
constexpr size_t MiB = 1u << 20;
constexpr size_t WS_MOD = 0;
constexpr size_t WS_CTL = 512 * 1024;
constexpr size_t WS_COS = 1 * MiB, WS_SIN = 3 * MiB;
constexpr size_t WS_WINE = 6 * MiB;
constexpr size_t WS_WOE = 10 * MiB;
constexpr size_t WS_WINO = 12 * MiB;
constexpr size_t WS_WOO = 17 * MiB;
constexpr size_t WS_W13 = 19 * MiB;
constexpr size_t WS_W2 = 41 * MiB;
constexpr size_t WS_PW = 52 * MiB;
constexpr size_t WS_HA = 54 * MiB;
constexpr size_t WS_ZR = 150 * MiB;
constexpr size_t WS_END = 414 * MiB;
constexpr int LDS_BYTES = 147456;

#define LAS __attribute__((address_space(3)))
typedef unsigned short bf16;
typedef unsigned v4u __attribute__((ext_vector_type(4)));
typedef unsigned v2u __attribute__((ext_vector_type(2)));
typedef float f32x4 __attribute__((ext_vector_type(4)));
typedef float f32x16 __attribute__((ext_vector_type(16)));
typedef short bf16x8 __attribute__((ext_vector_type(8)));
typedef short s16x4 __attribute__((ext_vector_type(4)));
#define LDS_WAIT() asm volatile("s_waitcnt lgkmcnt(0)" ::: "memory")
__device__ __forceinline__ unsigned f2bf(float f) { unsigned u = __builtin_bit_cast(unsigned, f); return (u + 0x7fffu + ((u >> 16) & 1u)) >> 16; }
__device__ __forceinline__ unsigned pk2(float lo, float hi) { return f2bf(lo) | (f2bf(hi) << 16); }
__device__ __forceinline__ float bflo(unsigned w) { return __builtin_bit_cast(float, w << 16); }
__device__ __forceinline__ float bfhi(unsigned w) { return __builtin_bit_cast(float, w & 0xffff0000u); }
__device__ __forceinline__ float wave_sum(float v) {
#pragma unroll
    for (int o = 1; o < 64; o <<= 1) v += __shfl_xor(v, o);
    return v;
}
__device__ __forceinline__ int crow(int r, int hi) { return (r & 3) + 8 * (r >> 2) + 4 * hi; }

struct Args {
    const float *x_p, *x_s, *c_p, *c_s, *ada_w, *ada_b, *norm_g, *final_g, *w1, *w3, *w2, *even_w_in, *rpb, *pool_w, *pool_scale, *even_w_out,
                *odd_w_in, *sink, *conv_w, *conv_b, *odd_w_out;
    float* out; unsigned char* ws;
};

template <class RowMap>
__device__ __forceinline__ void p0_transpose_item(const float* W, int K, int N, bf16* WT, LAS float* scr, int item, int lane, RowMap rowmap) {
    const int nblk = N / 32, kb = item / nblk, nb = item % nblk, k0 = 64 * kb, n0 = 32 * nb;
#pragma unroll 8
    for (int i = 0; i < 32; ++i) { const int kk = 2 * i + (lane >> 5); scr[kk * 33 + (lane & 31)] = W[(size_t)(k0 + kk) * N + n0 + (lane & 31)]; }
    LDS_WAIT(); asm volatile("" ::: "memory");
    const int c = lane & 7;
#pragma unroll
    for (int j = 0; j < 4; ++j) { const int n = (lane >> 3) + 8 * j; const LAS float* s = scr + (8 * c) * 33 + n;
        v4u o; o.x = pk2(s[0 * 33], s[1 * 33]); o.y = pk2(s[2 * 33], s[3 * 33]); o.z = pk2(s[4 * 33], s[5 * 33]); o.w = pk2(s[6 * 33], s[7 * 33]);
        *(v4u*)(WT + (size_t)rowmap(n0 + n) * K + k0 + 8 * c) = o; }
    LDS_WAIT(); asm volatile("" ::: "memory");
}
struct MapId { __device__ __forceinline__ int operator()(int n) const { return n; } };
struct MapRope { __device__ __forceinline__ int operator()(int n) const { if (n >= 640) return n; const int d = n & 63; return (n & ~63) + ((d & 31) << 1) + (d >> 5); } };
struct MapW1 { __device__ __forceinline__ int operator()(int n) const { return ((n >> 7) << 8) + (n & 127); } };
struct MapW3 { __device__ __forceinline__ int operator()(int n) const { return ((n >> 7) << 8) + 128 + (n & 127); } };

__device__ __forceinline__ int batch_of(int row) { return row < TP ? (row >> 12) : 4 + ((row - TP) >> 14); }

__device__ __forceinline__ void norm_row(const float* xrow, const float* gam, const float* sh, const float* sc, bf16* orow, int lane) {
    const f32x4* xr = (const f32x4*)xrow + lane;
    f32x4 v[4]; float s = 0.f;
#pragma unroll
    for (int j = 0; j < 4; ++j) { v[j] = xr[64 * j]; s += (v[j].x * v[j].x + v[j].y * v[j].y) + (v[j].z * v[j].z + v[j].w * v[j].w); }
    const float rstd = 1.f / sqrtf(wave_sum(s) * (1.f / D) + EPS);
    unsigned long long* o8 = (unsigned long long*)orow + lane;
#pragma unroll
    for (int j = 0; j < 4; ++j) { const f32x4 g = ((const f32x4*)gam)[lane + 64 * j], a = ((const f32x4*)sc)[lane + 64 * j], b = ((const f32x4*)sh)[lane + 64 * j];
        const f32x4 y = (v[j] * rstd) * g * (a + 1.0f) + b;
        o8[64 * j] = (unsigned long long)pk2(y.x, y.y) | ((unsigned long long)pk2(y.z, y.w) << 32); }
}
__device__ __forceinline__ void norm_phase(const Args& A, const float* srcA, const float* srcB, int layer, int which, int gw, int NGW, int lane) {
    const float* mod = (const float*)(A.ws + WS_MOD) + (size_t)layer * NB * 6144 + which * 3072;
    const float* gam = A.norm_g + (layer * 2 + which) * D;
    bf16* H = (bf16*)(A.ws + WS_HA);
    for (int m = gw; m < T; m += NGW) {
        const int b = batch_of(m); const float* xrow = m < TP ? srcA + (size_t)m * D : srcB + (size_t)(m - TP) * D;
        norm_row(xrow, gam, mod + (size_t)b * 6144, mod + (size_t)b * 6144 + 1024, H + (size_t)m * D, lane);
    }
}

#define MFMA32(a, b, c) __builtin_amdgcn_mfma_f32_32x32x16_bf16((a), (b), (c), 0, 0, 0)
template <class SF>
__device__ __forceinline__ void flash_tile(const bf16* Kp, const bf16* Vp, int ldz, LAS unsigned char* vt, const bf16x8 (&qf)[4], float& m, float& l, f32x16 (&o)[2], int lane, const SF& sf) {
    const int r32 = lane & 31, hi = lane >> 5;
    bf16x8 kf[4];
#pragma unroll
    for (int ds = 0; ds < 4; ++ds) kf[ds] = *(const bf16x8*)(Kp + (size_t)r32 * ldz + 16 * ds + 8 * hi);
    v4u vld[4];
#pragma unroll
    for (int i = 0; i < 4; ++i) vld[i] = *(const v4u*)(Vp + (size_t)((lane >> 3) + 8 * i) * ldz + (lane & 7) * 8);
    f32x16 p = {};
#pragma unroll
    for (int ds = 0; ds < 4; ++ds) p = MFMA32(kf[ds], qf[ds], p);
#pragma unroll
    for (int i = 0; i < 4; ++i) *(LAS v4u*)(vt + ((lane >> 3) + 8 * i) * 128 + (lane & 7) * 16) = vld[i];
    float mx = -INFINITY;
#pragma unroll
    for (int r = 0; r < 16; ++r) { p[r] = sf(p[r], r); mx = fmaxf(mx, p[r]); }
    mx = fmaxf(mx, __shfl_xor(mx, 32));
    const float mnew = fmaxf(m, mx), alpha = __builtin_amdgcn_exp2f(m - mnew);
    float rs = 0.f;
#pragma unroll
    for (int r = 0; r < 16; ++r) { p[r] = __builtin_amdgcn_exp2f(p[r] - mnew); rs += p[r]; }
    l = l * alpha + rs; m = mnew;
#pragma unroll
    for (int r = 0; r < 16; ++r) { o[0][r] *= alpha; o[1][r] *= alpha; }
    bf16x8 pb[2];
#pragma unroll
    for (int s = 0; s < 2; ++s) { v4u w; w.x = pk2(p[8 * s], p[8 * s + 1]); w.y = pk2(p[8 * s + 2], p[8 * s + 3]); w.z = pk2(p[8 * s + 4], p[8 * s + 5]); w.w = pk2(p[8 * s + 6], p[8 * s + 7]); pb[s] = __builtin_bit_cast(bf16x8, w); }
    LDS_WAIT();
    const int i16 = lane & 15, q4 = i16 >> 2, p4 = i16 & 3, blk = (lane >> 4) & 1;
#pragma unroll
    for (int dh = 0; dh < 2; ++dh)
#pragma unroll
        for (int s = 0; s < 2; ++s) {
            const LAS unsigned char* a0 = vt + (16 * s + 4 * hi + q4) * 128 + (32 * dh + 16 * blk) * 2 + 8 * p4;
            const s16x4 lo = __builtin_bit_cast(s16x4, __builtin_amdgcn_ds_read_tr16_b64_v4i16((LAS s16x4*)a0));
            const s16x4 hh = __builtin_bit_cast(s16x4, __builtin_amdgcn_ds_read_tr16_b64_v4i16((LAS s16x4*)(a0 + 8 * 128)));
            const bf16x8 vf = __builtin_shufflevector(lo, hh, 0, 1, 2, 3, 4, 5, 6, 7);
            o[dh] = MFMA32(vf, pb[s], o[dh]);
        }
    LDS_WAIT();
}
__device__ __forceinline__ void flash_store(bf16* orow, const f32x16 (&o)[2], float l, int lane) {
    const int hi = lane >> 5; const float inv = 1.0f / (l + __shfl_xor(l, 32));
#pragma unroll
    for (int dh = 0; dh < 2; ++dh)
#pragma unroll
        for (int g = 0; g < 4; ++g) { v2u w; w.x = pk2(o[dh][4 * g] * inv, o[dh][4 * g + 1] * inv); w.y = pk2(o[dh][4 * g + 2] * inv, o[dh][4 * g + 3] * inv);
            *(v2u*)(orow + 32 * dh + 8 * g + 4 * hi) = w; }
}

__device__ __forceinline__ void p0_phase(const Args& A, LAS unsigned char* lds, int tid, int lane, int wave, int G) {
    float* mod = (float*)(A.ws + WS_MOD);
    {
        LAS float* cact = (LAS float*)lds;
        LAS float* part = (LAS float*)(lds + 24576);
        for (int i = tid; i < NB * D; i += NWAVES * 64) { const int b = i >> 10, k = i & 1023; const float c = b < 4 ? A.c_p[b * D + k] : A.c_s[(b - 4) * D + k]; cact[i] = c / (1.0f + __expf(-c)); }
        __syncthreads();
        for (int cb = blockIdx.x; cb < 2 * 6144 / 64; cb += G) {
            const int layer = cb / 96, j = (cb % 96) * 64 + lane; const float* w = A.ada_w + (size_t)layer * D * 6144 + j;
            float acc[NB] = {0.f, 0.f, 0.f, 0.f, 0.f, 0.f};
            const int k0 = wave * 128;
#pragma unroll 16
            for (int k = 0; k < 128; ++k) { const float wv = w[(size_t)(k0 + k) * 6144];
#pragma unroll
                for (int b = 0; b < NB; ++b) acc[b] += cact[b * D + k0 + k] * wv; }
#pragma unroll
            for (int b = 0; b < NB; ++b) part[(wave * NB + b) * 64 + lane] = acc[b];
            __syncthreads();
            if (wave < NB) { float s = A.ada_b[layer * 6144 + j];
#pragma unroll
                for (int w8 = 0; w8 < NWAVES; ++w8) s += part[(w8 * NB + wave) * 64 + lane];
                mod[((size_t)layer * NB + wave) * 6144 + j] = s; }
            __syncthreads();
        }
    }
    const int gw = blockIdx.x * NWAVES + wave, NGW = G * NWAVES;
    {
        float* cosT = (float*)(A.ws + WS_COS); float* sinT = (float*)(A.ws + WS_SIN);
        for (int i = blockIdx.x * NWAVES * 64 + tid; i < 16384 * 32; i += G * NWAVES * 64) {
            const int pos = i >> 5, k = i & 31; const float inv = 1.0f / powf(10000.0f, (float)(2 * k) / 64.0f); const float ang = (float)pos * inv;
            double s, c; sincos((double)ang, &s, &c); cosT[i] = (float)c; sinT[i] = (float)s; }
    }
    {
        LAS float* scr = (LAS float*)(lds + 65536 + wave * 8704);
        constexpr int I_WINE = 16 * 64, I_WO = 16 * 32, I_WINO = 16 * 72, I_W1 = 16 * 88, I_W2 = 44 * 32, I_PW = 2 * 4;
        constexpr int NITEMS = I_WINE + 2 * I_WO + I_WINO + 4 * I_W1 + 2 * I_W2 + 4 * I_PW;
        bf16* ws16 = (bf16*)A.ws;
        for (int it = gw; it < NITEMS; it += NGW) {
            int r = it;
            if (r < I_WINE) { p0_transpose_item(A.even_w_in, D, EVEN_IN, (bf16*)(A.ws + WS_WINE), scr, r, lane, MapId()); continue; } r -= I_WINE;
            if (r < I_WO) { p0_transpose_item(A.even_w_out, D, D, (bf16*)(A.ws + WS_WOE), scr, r, lane, MapId()); continue; } r -= I_WO;
            if (r < I_WO) { p0_transpose_item(A.odd_w_out, D, D, (bf16*)(A.ws + WS_WOO), scr, r, lane, MapId()); continue; } r -= I_WO;
            if (r < I_WINO) { p0_transpose_item(A.odd_w_in, D, ODD_IN, (bf16*)(A.ws + WS_WINO), scr, r, lane, MapRope()); continue; } r -= I_WINO;
            if (r < 2 * I_W1) { const int l = r / I_W1; p0_transpose_item(A.w1 + (size_t)l * D * DFF, D, DFF, (bf16*)(A.ws + WS_W13) + (size_t)l * 5632 * D, scr, r % I_W1, lane, MapW1()); continue; } r -= 2 * I_W1;
            if (r < 2 * I_W1) { const int l = r / I_W1; p0_transpose_item(A.w3 + (size_t)l * D * DFF, D, DFF, (bf16*)(A.ws + WS_W13) + (size_t)l * 5632 * D, scr, r % I_W1, lane, MapW3()); continue; } r -= 2 * I_W1;
            if (r < 2 * I_W2) { const int l = r / I_W2; p0_transpose_item(A.w2 + (size_t)l * DFF * D, DFF, D, (bf16*)(A.ws + WS_W2) + (size_t)l * D * DFF, scr, r % I_W2, lane, MapId()); continue; } r -= 2 * I_W2;
            { const int g = r / I_PW; p0_transpose_item(A.pool_w + (size_t)g * 128 * 128, 128, 128, (bf16*)(A.ws + WS_PW) + (size_t)g * 128 * 128, scr, r % I_PW, lane, MapId()); }
        }
        (void)ws16;
    }
}

struct SfNA { const LAS float* rp; int cq, cs, kc0, hi;
    __device__ __forceinline__ float operator()(float p, int r) const { const int kc = kc0 + crow(r, hi); const bool ok = (kc >= cs) && (kc < cs + 16); int dc = kc - cq + 15; dc = dc < 0 ? 0 : (dc > 30 ? 30 : dc);
        return ok ? (p * 0.125f + rp[dc]) * LOG2E : -INFINITY; } };
__device__ __forceinline__ void even_mixer_phase(const Args& A, LAS unsigned char* lds, int tid, int lane, int wave, int G) {
    const bf16* Z = (const bf16*)(A.ws + WS_ZR); bf16* AO = (bf16*)(A.ws + WS_HA);
    LAS float* rpb = (LAS float*)lds;
    for (int i = tid; i < 8 * 15 * 31; i += NWAVES * 64) rpb[i] = A.rpb[i];
    __syncthreads();
    LAS unsigned char* vt = lds + 16384 + wave * 4096;
    const int gw = blockIdx.x * NWAVES + wave, NGW = G * NWAVES; const int r32 = lane & 31, hi = lane >> 5;
    constexpr int NTT = T / 32;
#pragma unroll 1
    for (int it = gw; it < NTT * 8; it += NGW) {
        const int hh = it / NTT, tt = it % NTT, t0 = tt * 32;
        const int L = t0 < TP ? LP : LS, rows = L / 64, pos0 = t0 & (L - 1), sb = t0 - pos0;
        const int r = pos0 >> 6, cq = (pos0 & 63) + r32; int cs = cq - 8; cs = cs < 0 ? 0 : (cs > 48 ? 48 : cs);
        int rs = r - 4; rs = rs < 0 ? 0 : (rs > rows - 8 ? rows - 8 : rs);
        bf16x8 qf[4];
#pragma unroll
        for (int ds = 0; ds < 4; ++ds) qf[ds] = *(const bf16x8*)(Z + (size_t)(t0 + r32) * EVEN_IN + hh * 64 + 16 * ds + 8 * hi);
        float m = -1e30f, l = 0.f; f32x16 o[2]; o[0] = f32x16{}; o[1] = f32x16{};
#pragma unroll 1
        for (int i = 0; i < 8; ++i) { const int kr = rs + i, dr = kr - r + 7;
#pragma unroll 1
            for (int ct = 0; ct < 2; ++ct) { const size_t tk0 = (size_t)sb + kr * 64 + ct * 32;
                SfNA sf{rpb + (hh * 15 + dr) * 31, cq, cs, ct * 32, hi};
                flash_tile(Z + tk0 * EVEN_IN + 512 + hh * 64, Z + tk0 * EVEN_IN + 1024 + hh * 64, EVEN_IN, vt, qf, m, l, o, lane, sf); } }
        flash_store(AO + (size_t)(t0 + r32) * D + hh * 64, o, l, lane);
    }
    const bf16* PW = (const bf16*)(A.ws + WS_PW);
#pragma unroll 1
    for (int it = gw; it < NTT * 4; it += NGW) {
        const int g = it / NTT, tt = it % NTT, t0 = tt * 32, w = 2 << g, half = w >> 1;
        const int L = t0 < TP ? LP : LS, pos0 = t0 & (L - 1), sb = t0 - pos0, pos = pos0 + r32;
        const int lo = pos - half < 0 ? 0 : pos - half, hiw = pos + half > L ? L : pos + half; const float rc = 1.0f / (float)(hiw - lo);
        const bf16* ub = Z + 1536 + g * 128 + 8 * hi;
        bf16x8 bfr[8];
#pragma unroll
        for (int ks = 0; ks < 8; ++ks) {
            float sm[8] = {0.f, 0.f, 0.f, 0.f, 0.f, 0.f, 0.f, 0.f};
            for (int j = 0; j < w; ++j) { const int tp = pos - half + j; if (tp >= 0 && tp < L) { const v4u v = *(const v4u*)(ub + (size_t)(sb + tp) * EVEN_IN + 16 * ks);
                sm[0] += bflo(v.x); sm[1] += bfhi(v.x); sm[2] += bflo(v.y); sm[3] += bfhi(v.y); sm[4] += bflo(v.z); sm[5] += bfhi(v.z); sm[6] += bflo(v.w); sm[7] += bfhi(v.w); } }
            const v4u u = *(const v4u*)(ub + (size_t)(sb + pos) * EVEN_IN + 16 * ks);
            v4u mx; mx.x = pk2(sm[0] * rc - bflo(u.x), sm[1] * rc - bfhi(u.x)); mx.y = pk2(sm[2] * rc - bflo(u.y), sm[3] * rc - bfhi(u.y));
            mx.z = pk2(sm[4] * rc - bflo(u.z), sm[5] * rc - bfhi(u.z)); mx.w = pk2(sm[6] * rc - bflo(u.w), sm[7] * rc - bfhi(u.w));
            bfr[ks] = __builtin_bit_cast(bf16x8, mx);
        }
#pragma unroll
        for (int et = 0; et < 4; ++et) { f32x16 acc = {};
#pragma unroll
            for (int ks = 0; ks < 8; ++ks) { const bf16x8 af = *(const bf16x8*)(PW + (size_t)g * 16384 + (size_t)(32 * et + r32) * 128 + 16 * ks + 8 * hi); acc = MFMA32(af, bfr[ks], acc); }
            bf16* orow = AO + (size_t)(t0 + r32) * D + 512 + g * 128 + 32 * et; const float* scl = A.pool_scale + g * 128 + 32 * et;
#pragma unroll
            for (int q = 0; q < 4; ++q) { const f32x4 sv = *(const f32x4*)(scl + 8 * q + 4 * hi); v2u wv; wv.x = pk2(acc[4 * q] * sv.x, acc[4 * q + 1] * sv.y); wv.y = pk2(acc[4 * q + 2] * sv.z, acc[4 * q + 3] * sv.w);
                *(v2u*)(orow + 8 * q + 4 * hi) = wv; } }
    }
}

struct SfSWA { int mode, qi, hi;
    __device__ __forceinline__ float operator()(float p, int r) const { const int ki = crow(r, hi); const bool ok = mode == 0 || (mode < 0 ? ki >= qi : ki <= qi); return ok ? p * (0.125f * LOG2E) : -INFINITY; } };
__device__ __forceinline__ void odd_mixer_phase(const Args& A, LAS unsigned char* lds, int tid, int lane, int wave, int G) {
    const bf16* Z = (const bf16*)(A.ws + WS_ZR); bf16* AO = (bf16*)(A.ws + WS_HA);
    LAS unsigned char* vt = lds + 16384 + wave * 4096;
    const int gw = blockIdx.x * NWAVES + wave, NGW = G * NWAVES; const int r32 = lane & 31, hi = lane >> 5;
    constexpr int NTT = T / 32;
#pragma unroll 1
    for (int it = gw; it < NTT * 8; it += NGW) {
        const int hq = it / NTT, tt = it % NTT, t0 = tt * 32, kvh = hq >> 2;
        const int L = t0 < TP ? LP : LS, pos0 = t0 & (L - 1), sb = t0 - pos0;
        bf16x8 qf[4];
#pragma unroll
        for (int ds = 0; ds < 4; ++ds) qf[ds] = *(const bf16x8*)(Z + (size_t)(t0 + r32) * ODD_IN + hq * 64 + 16 * ds + 8 * hi);
        float m = A.sink[hq] * LOG2E, l = hi == 0 ? 1.0f : 0.0f; f32x16 o[2]; o[0] = f32x16{}; o[1] = f32x16{};
#pragma unroll 1
        for (int jt = -4; jt <= 4; ++jt) { const int kp0 = pos0 + 32 * jt; if (kp0 < 0 || kp0 >= L) continue;
            const size_t tk0 = (size_t)sb + kp0; SfSWA sf{jt == -4 ? -1 : (jt == 4 ? 1 : 0), r32, hi};
            flash_tile(Z + tk0 * ODD_IN + 512 + kvh * 64, Z + tk0 * ODD_IN + 640 + kvh * 64, ODD_IN, vt, qf, m, l, o, lane, sf); }
        flash_store(AO + (size_t)(t0 + r32) * D + hq * 64, o, l, lane);
    }
    for (size_t i = (size_t)blockIdx.x * NWAVES * 64 + tid; i < (size_t)T * 64; i += (size_t)G * NWAVES * 64) {
        const int t = (int)(i >> 6), c = (int)(i & 63) * 8; const int L = t < TP ? LP : LS, pos = t & (L - 1);
        const bf16* zr = Z + (size_t)t * ODD_IN; const v4u bg = *(const v4u*)(zr + 768 + c);
        float cv[8]; { const f32x4 b0 = *(const f32x4*)(A.conv_b + c), b1 = *(const f32x4*)(A.conv_b + c + 4); cv[0] = b0.x; cv[1] = b0.y; cv[2] = b0.z; cv[3] = b0.w; cv[4] = b1.x; cv[5] = b1.y; cv[6] = b1.z; cv[7] = b1.w; }
#pragma unroll
        for (int j = 0; j < 3; ++j) { const int tp = pos + j - 1; if (tp < 0 || tp >= L) continue;
            const bf16* zp = zr + (ptrdiff_t)(j - 1) * ODD_IN; const v4u cgv = *(const v4u*)(zp + 1280 + c), xv = *(const v4u*)(zp + 1792 + c);
            const f32x4 w0 = *(const f32x4*)(A.conv_w + j * 512 + c), w1 = *(const f32x4*)(A.conv_w + j * 512 + c + 4);
            cv[0] += w0.x * (bflo(cgv.x) * bflo(xv.x)); cv[1] += w0.y * (bfhi(cgv.x) * bfhi(xv.x)); cv[2] += w0.z * (bflo(cgv.y) * bflo(xv.y)); cv[3] += w0.w * (bfhi(cgv.y) * bfhi(xv.y));
            cv[4] += w1.x * (bflo(cgv.z) * bflo(xv.z)); cv[5] += w1.y * (bfhi(cgv.z) * bfhi(xv.z)); cv[6] += w1.z * (bflo(cgv.w) * bflo(xv.w)); cv[7] += w1.w * (bfhi(cgv.w) * bfhi(xv.w)); }
        v4u o; o.x = pk2(bflo(bg.x) * cv[0], bfhi(bg.x) * cv[1]); o.y = pk2(bflo(bg.y) * cv[2], bfhi(bg.y) * cv[3]); o.z = pk2(bflo(bg.z) * cv[4], bfhi(bg.z) * cv[5]); o.w = pk2(bflo(bg.w) * cv[6], bfhi(bg.w) * cv[7]);
        *(v4u*)(AO + (size_t)t * D + 512 + c) = o;
    }
}

#define XB_TMO      128
#define XB_XCNT(j)  (256  + 64 * (j))
#define XB_XSUB(j)  (1280 + 64 * (j))
#define XB_XGEN(j)  (2304 + 64 * (j))
#define XB_TOP      3328
#define XB_TOPGEN   3392
#define XCD_BAR_WORDS 3456
#define XB_SPIN_CAP (1u << 18)

__device__ __forceinline__ unsigned xb_ld(unsigned* p)              { return __hip_atomic_load(p, __ATOMIC_RELAXED, __HIP_MEMORY_SCOPE_AGENT); }
__device__ __forceinline__ unsigned xb_add(unsigned* p, unsigned v) { return __hip_atomic_fetch_add(p, v, __ATOMIC_RELAXED, __HIP_MEMORY_SCOPE_AGENT); }
__device__ __forceinline__ unsigned xb_xcc_id() { return (unsigned)__builtin_amdgcn_s_getreg((3 << 11) | 20) & 0xFu; }
#define XB_SPIN(cond, bar) do { unsigned _sp = 0; while (cond) { __builtin_amdgcn_s_sleep(1); \
    if ((++_sp & 255u) == 0u) { if (xb_ld(&(bar)[XB_TMO])) break; if (_sp > XB_SPIN_CAP) { atomicAdd(&(bar)[XB_TMO], 1u); break; } } } } while (0)

struct XcdBarrier {
    unsigned* bar; unsigned x;
    volatile LAS unsigned* st;
};

__device__ __forceinline__ XcdBarrier xcd_barrier_post(unsigned* bar, volatile LAS unsigned* st) {
    XcdBarrier b; b.bar = bar; b.x = xb_xcc_id(); b.st = st;
    if (threadIdx.x == 0) (void)xb_add(&bar[XB_XCNT(b.x)], 1u);
    return b;
}
__device__ __forceinline__ void xcd_barrier_complete(unsigned* bar, unsigned x, unsigned& nloc, unsigned& nx) {
    const unsigned G = gridDim.x * gridDim.y * gridDim.z;
    unsigned sum, cnt, mine, sp = 0u;
    for (;;) {
        sum = 0u; cnt = 0u; mine = 0u;
#pragma unroll
        for (unsigned j = 0; j < 16; ++j) { const unsigned c = xb_ld(&bar[XB_XCNT(j)]); sum += c; cnt += (c > 0u) ? 1u : 0u; mine = (j == x) ? c : mine; }
        if (sum == G) break;
        __builtin_amdgcn_s_sleep(1);
        if ((++sp & 255u) == 0u) { if (xb_ld(&bar[XB_TMO])) break; if (sp > XB_SPIN_CAP) { atomicAdd(&bar[XB_TMO], 1u); break; } }
    }
    nloc = mine > 0u ? mine : 1u; nx = cnt > 0u ? cnt : 1u;
}

__device__ __forceinline__ void xcd_barrier(const XcdBarrier& b) {
    asm volatile("s_waitcnt vmcnt(0)" ::: "memory");
    __syncthreads();
    if (threadIdx.x == 0) {
        unsigned* bar = b.bar;
        __builtin_amdgcn_s_waitcnt(0);
        unsigned nloc = b.st[0], nx = b.st[1];
        if (nloc == 0u) { xcd_barrier_complete(bar, b.x, nloc, nx); b.st[0] = nloc; b.st[1] = nx; }
        const unsigned old = xb_add(&bar[XB_XSUB(b.x)], 1u);
        const unsigned gen = old / nloc;
        if (old + 1u == (gen + 1u) * nloc) {
            __builtin_amdgcn_fence(__ATOMIC_RELEASE, "agent");
            asm volatile("s_waitcnt vmcnt(0)" ::: "memory");
            const unsigned og = xb_add(&bar[XB_TOP], 1u);
            const unsigned tg = og / nx;
            if (og + 1u == (tg + 1u) * nx) xb_add(&bar[XB_TOPGEN], 1u);
            else XB_SPIN(xb_ld(&bar[XB_TOPGEN]) == tg, bar);
            __builtin_amdgcn_fence(__ATOMIC_ACQUIRE, "agent");
            xb_add(&bar[XB_XGEN(b.x)], 1u);
            asm volatile("s_waitcnt vmcnt(0)" ::: "memory");
        } else {
            XB_SPIN(xb_ld(&bar[XB_XGEN(b.x)]) == gen, bar);
            __builtin_amdgcn_fence(__ATOMIC_ACQUIRE, "agent");
            asm volatile("s_waitcnt vmcnt(0)" ::: "memory");
        }
    }
    __syncthreads();
}

__global__ void __launch_bounds__(NWAVES * 64, 2) hybrid_fwd(Args A) {
    extern __shared__ __attribute__((aligned(16))) unsigned char lds_raw[];
    LAS unsigned char* lds = (LAS unsigned char*)lds_raw;
    cg::grid_group grid = cg::this_grid();
    int tid = threadIdx.x, lane = tid & 63, wave = __builtin_amdgcn_readfirstlane(tid >> 6); const int G = gridDim.x;
    int gw = blockIdx.x * NWAVES + wave; const int NGW = G * NWAVES;
    float* const X = A.out; const float* const mod = (const float*)(A.ws + WS_MOD);
    bf16* const HA = (bf16*)(A.ws + WS_HA); bf16* const ZR = (bf16*)(A.ws + WS_ZR);
    const float* cosT = (const float*)(A.ws + WS_COS); const float* sinT = (const float*)(A.ws + WS_SIN);

#define RELAUNDER() do { int t_ = threadIdx.x; asm volatile("" : "+v"(t_)); tid = t_; lane = tid & 63; wave = __builtin_amdgcn_readfirstlane(tid >> 6); gw = blockIdx.x * NWAVES + wave; } while (0)
    p0_phase(A, lds, tid, lane, wave, G);
    { unsigned* bw = (unsigned*)(A.ws + WS_CTL); if (blockIdx.x == 0) for (int i = threadIdx.x; i < XCD_BAR_WORDS; i += NWAVES * 64) __hip_atomic_store(bw + i, 0u, __ATOMIC_RELAXED, __HIP_MEMORY_SCOPE_AGENT); }
    volatile LAS unsigned* bst = (volatile LAS unsigned*)(lds + 143360);
    if (threadIdx.x < 2) bst[threadIdx.x] = 0u;
    grid.sync();
    const XcdBarrier xbar = xcd_barrier_post((unsigned*)(A.ws + WS_CTL), bst);
#pragma unroll 1
    for (int layer = 0; layer < 2; ++layer) {
        const float* srcA = layer == 0 ? A.x_p : X; const float* srcB = layer == 0 ? A.x_s : X + (size_t)TP * D;
        RELAUNDER(); norm_phase(A, srcA, srcB, layer, 0, gw, NGW, lane);
        xcd_barrier(xbar);
        {
            const int N = layer == 0 ? EVEN_IN : ODD_IN;
            pg8::Gemm g{HA, (const bf16*)(A.ws + (layer == 0 ? WS_WINE : WS_WINO)), T, N, D}; pg8::StaticOrder S; S.init(T, N, G, (int)blockIdx.x);
            pg8::EpiBf16R E{ZR, N, layer == 0 ? 0 : 640, cosT, sinT};
            pg8::gemm_phase<pg8::EpiBf16R, pg8::StaticOrder, true, true>(lds, g, S, E);
        }
        xcd_barrier(xbar);
        RELAUNDER();
        if (layer == 0) even_mixer_phase(A, lds, tid, lane, wave, G); else odd_mixer_phase(A, lds, tid, lane, wave, G);
        xcd_barrier(xbar);
        {
            pg8::Gemm g{HA, (const bf16*)(A.ws + (layer == 0 ? WS_WOE : WS_WOO)), T, D, D}; pg8::StaticOrder S; S.init(T, D, G, (int)blockIdx.x);
            pg8::EpiRes E{srcA, srcB, X, mod + (size_t)layer * NB * 6144 + 2048};
            pg8::gemm_phase<pg8::EpiRes, pg8::StaticOrder, true, true>(lds, g, S, E);
        }
        xcd_barrier(xbar);
        RELAUNDER(); norm_phase(A, X, X + (size_t)TP * D, layer, 1, gw, NGW, lane);
        xcd_barrier(xbar);
        {
            pg8::Gemm g{HA, (const bf16*)(A.ws + WS_W13) + (size_t)layer * 5632 * D, T, 5632, D}; pg8::StaticOrder S; S.init(T, 5632, G, (int)blockIdx.x);
            pg8::EpiSwiGLU E{ZR, DFF};
            pg8::gemm_phase<pg8::EpiSwiGLU, pg8::StaticOrder, true, true>(lds, g, S, E);
        }
        xcd_barrier(xbar);
        {
            pg8::Gemm g{ZR, (const bf16*)(A.ws + WS_W2) + (size_t)layer * D * DFF, T, D, DFF}; pg8::StaticOrder S; S.init(T, D, G, (int)blockIdx.x);
            pg8::EpiRes E{X, X + (size_t)TP * D, X, mod + (size_t)layer * NB * 6144 + 5120};
            pg8::gemm_phase<pg8::EpiRes, pg8::StaticOrder, true, true>(lds, g, S, E);
        }
        xcd_barrier(xbar);
    }
    RELAUNDER();
    for (int mrow = gw; mrow < T; mrow += NGW) {
        f32x4* xr = (f32x4*)(X + (size_t)mrow * D) + lane; f32x4 v[4]; float s = 0.f;
#pragma unroll
        for (int j = 0; j < 4; ++j) { v[j] = xr[64 * j]; s += (v[j].x * v[j].x + v[j].y * v[j].y) + (v[j].z * v[j].z + v[j].w * v[j].w); }
        const float rstd = 1.f / sqrtf(wave_sum(s) * (1.f / D) + EPS);
#pragma unroll
        for (int j = 0; j < 4; ++j) xr[64 * j] = (v[j] * rstd) * ((const f32x4*)A.final_g)[lane + 64 * j];
    }
}

extern "C" void kernel_launch(void* const* d_in, const int* in_sizes, int n_in, void* d_out, int out_size, void* d_ws, size_t ws_size, hipStream_t stream) {
    static int grid = 0;
    if (grid == 0) {
        if (n_in != 21 || out_size != T * D || ws_size < WS_END) { fprintf(stderr, "kernel_launch: unexpected shapes (n_in %d out %d ws %zu)\n", n_in, out_size, ws_size); grid = -1; return; }
        int dev = 0, cus = 0, per_cu = 0;
        hipGetDevice(&dev); hipDeviceGetAttribute(&cus, hipDeviceAttributeMultiprocessorCount, dev);
        hipFuncSetAttribute((const void*)hybrid_fwd, hipFuncAttributeMaxDynamicSharedMemorySize, LDS_BYTES);
        if (hipOccupancyMaxActiveBlocksPerMultiprocessor(&per_cu, (const void*)hybrid_fwd, NWAVES * 64, LDS_BYTES) != hipSuccess || per_cu < 1) per_cu = 1;
        (void)hipGetLastError();
        grid = cus * per_cu;
    }
    if (grid < 0) return;
    Args a{};
    const float** p = (const float**)&a;
    for (int i = 0; i < 21; ++i) p[i] = (const float*)d_in[i];
    a.out = (float*)d_out; a.ws = (unsigned char*)d_ws;
    void* args[] = {&a};
    hipError_t e = hipLaunchCooperativeKernel((const void*)hybrid_fwd, dim3(grid), dim3(NWAVES * 64), args, LDS_BYTES, stream);
    if (e != hipSuccess) fprintf(stderr, "cooperative launch failed: %s (grid %d)\n", hipGetErrorString(e), grid);
}
```

```cpp
#include <hip/hip_runtime.h>
#include <hip/hip_cooperative_groups.h>
#include <cstdio>
#include <cstdint>
namespace cg = cooperative_groups;
namespace pg8 {
#define PG8_LAS __attribute__((address_space(3)))
typedef unsigned short bf16_t;
typedef short bf16x8 __attribute__((ext_vector_type(8)));
typedef float f32x4 __attribute__((ext_vector_type(4)));
typedef unsigned u32x4 __attribute__((ext_vector_type(4)));
constexpr int BM = 256, BK = 64, HALF = 128, HTB = HALF * BK * 2  , STAGE_BYTES = 8 * HTB, NXCD = 8, WGM = 8;

__host__ __device__ __forceinline__ int lds_byte(int r, int c) { const int st = (r >> 4) * 2 + (c >> 5), rr = r & 15, cc = c & 31, ob = rr * 64 + cc * 2; return st * 1024 + (ob ^ (((ob >> 9) & 1) << 5)); }
__host__ __device__ __forceinline__ void stage_rc(int b, int& R, int& C) { const int st = b / 1024, sb = b % 1024, swz = sb ^ (((sb >> 9) & 1) << 5); R = (st >> 1) * 16 + swz / 64; C = (st & 1) * 32 + (swz % 64) / 2; }
__host__ __device__ __forceinline__ int perm32(int rho) { const int n = rho >> 4, i = rho & 15; return 8 * (i >> 2) + 4 * n + (i & 3); }

struct Unit { int pm, pn; };
struct Gemm { const bf16_t* A; const bf16_t* Bt; int M, N, K; };

struct StaticOrder {
    int nM, nN, nwg, G, c;
    __host__ __device__ void init(int M, int N, int G_, int c_) { nM = M / BM; nN = N / BM; nwg = nM * nN; G = G_; c = c_; }
    __host__ __device__ bool next(int i, Unit& u) const {
        const long L = (long)i * G + c; if (L >= nwg) return false;
        int wgid = (int)L; { const int q = nwg / NXCD, r = nwg % NXCD, xcd = wgid % NXCD, off = wgid / NXCD; wgid = (xcd < r ? xcd * (q + 1) : r * (q + 1) + (xcd - r) * q) + off; }
        const int nig = WGM * nN, gid = wgid / nig, fm = gid * WGM, gsz = (nM - fm) < WGM ? (nM - fm) : WGM;
        u.pm = fm + ((wgid % nig) % gsz); u.pn = (wgid % nig) / gsz; return true;
    }
    __device__ __forceinline__ void a_ready(const Unit&) const {}
    __device__ __forceinline__ void done(const Unit&) const {}
};

typedef float f32x2_t __attribute__((ext_vector_type(2))); typedef __bf16 bf16x2_t __attribute__((ext_vector_type(2)));
__device__ __forceinline__ unsigned cvt_pk_bf16(float lo, float hi) { f32x2_t v = {lo, hi}; bf16x2_t b = __builtin_convertvector(v, bf16x2_t); return __builtin_bit_cast(unsigned, b); }

__device__ __forceinline__ int epi_batch(int rbase) { return rbase < 16384 ? (rbase >> 12) : 4 + ((rbase - 16384) >> 14); }
struct EpiBf16R {
    static constexpr bool PERM = true, AFTER_DRAIN = false;
    bf16_t* O; int ldc; int rope_cols; const float* cosT; const float* sinT; const float* ssq; const float* sw; int swld;
    __device__ __forceinline__ void operator()(const f32x4 (&acc)[2][2][4][2], const Unit& u, int wr, int wc, int fr, int fq) const {
        const int row0 = u.pm * BM + wr * 64 + fr; const int col0 = u.pn * BM + wc * 32 + 8 * fq;
        const float* swp = sw + (size_t)epi_batch(u.pm * BM) * swld + col0;
        f32x4 swv[2][2];
#pragma unroll
        for (int bj = 0; bj < 2; ++bj) { swv[bj][0] = *(const f32x4*)(swp + bj * HALF); swv[bj][1] = *(const f32x4*)(swp + bj * HALF + 4); }
#pragma unroll
        for (int ai = 0; ai < 2; ++ai)
#pragma unroll
            for (int m = 0; m < 4; ++m) { const int row = row0 + ai * HALF + m * 16; bf16_t* rowp = O + (size_t)row * ldc + col0; const int pos = row & (row < 16384 ? 4095 : 16383);
                const float rstd = __builtin_amdgcn_rsqf(ssq[row] * (1.0f / 1024.0f) + 1e-6f);
#pragma unroll
                for (int bj = 0; bj < 2; ++bj) { f32x4 v0 = acc[ai][bj][m][0] * rstd + swv[bj][0], v1 = acc[ai][bj][m][1] * rstd + swv[bj][1];
                    const int c = col0 + bj * HALF;
                    if (c < rope_cols) { const int i0 = (c & 63) >> 1; const f32x4 cs = *(const f32x4*)(cosT + (size_t)pos * 32 + i0), sn = *(const f32x4*)(sinT + (size_t)pos * 32 + i0);
                        f32x4 w0, w1;
                        w0[0] = v0[0] * cs[0] - v0[1] * sn[0]; w0[1] = v0[0] * sn[0] + v0[1] * cs[0];
                        w0[2] = v0[2] * cs[1] - v0[3] * sn[1]; w0[3] = v0[2] * sn[1] + v0[3] * cs[1];
                        w1[0] = v1[0] * cs[2] - v1[1] * sn[2]; w1[1] = v1[0] * sn[2] + v1[1] * cs[2];
                        w1[2] = v1[2] * cs[3] - v1[3] * sn[3]; w1[3] = v1[2] * sn[3] + v1[3] * cs[3];
                        v0 = w0; v1 = w1; }
                    u32x4 w; w.x = cvt_pk_bf16(v0[0], v0[1]); w.y = cvt_pk_bf16(v0[2], v0[3]); w.z = cvt_pk_bf16(v1[0], v1[1]); w.w = cvt_pk_bf16(v1[2], v1[3]);
                    *(u32x4*)(rowp + bj * HALF) = w; } }
    }
};
__device__ __forceinline__ float silu_f(float x) { return x * __builtin_amdgcn_rcpf(1.0f + __builtin_amdgcn_exp2f(-1.4426950408889634f * x)); }
struct EpiSwiGLU {
    static constexpr bool PERM = true, AFTER_DRAIN = false;
    bf16_t* O; int ldc; const float* ssq; const float* sw;
    __device__ __forceinline__ void operator()(const f32x4 (&acc)[2][2][4][2], const Unit& u, int wr, int wc, int fr, int fq) const {
        const int row0 = u.pm * BM + wr * 64 + fr; const int col0 = u.pn * HALF + wc * 32 + 8 * fq;
        const float* swp = sw + (size_t)epi_batch(u.pm * BM) * 5632 + u.pn * BM + wc * 32 + 8 * fq;
        const f32x4 sg0 = *(const f32x4*)(swp), sg1 = *(const f32x4*)(swp + 4), su0 = *(const f32x4*)(swp + HALF), su1 = *(const f32x4*)(swp + HALF + 4);
#pragma unroll
        for (int ai = 0; ai < 2; ++ai)
#pragma unroll
            for (int m = 0; m < 4; ++m) { const int row = row0 + ai * HALF + m * 16; bf16_t* rowp = O + (size_t)row * ldc + col0;
                const float rstd = __builtin_amdgcn_rsqf(ssq[row] * (1.0f / 1024.0f) + 1e-6f);
                const f32x4 g0 = acc[ai][0][m][0] * rstd + sg0, g1 = acc[ai][0][m][1] * rstd + sg1, u0 = acc[ai][1][m][0] * rstd + su0, u1 = acc[ai][1][m][1] * rstd + su1;
                u32x4 w; w.x = cvt_pk_bf16(silu_f(g0[0]) * u0[0], silu_f(g0[1]) * u0[1]); w.y = cvt_pk_bf16(silu_f(g0[2]) * u0[2], silu_f(g0[3]) * u0[3]);
                w.z = cvt_pk_bf16(silu_f(g1[0]) * u1[0], silu_f(g1[1]) * u1[1]); w.w = cvt_pk_bf16(silu_f(g1[2]) * u1[2], silu_f(g1[3]) * u1[3]);
                *(u32x4*)rowp = w; }
    }
};
template <bool FUSE> struct EpiRes {
    static constexpr bool PERM = false, AFTER_DRAIN = false;
    const float* srcA; const float* srcB; float* out; const float* gate;
    float* ssqn; const float* gpn; bf16_t* xg;
    __device__ __forceinline__ void operator()(const f32x4 (&acc)[2][2][4][2], const Unit& u, int wr, int wc, int fr, int fq) const {
        const int rbase = u.pm * BM; const int row0 = rbase + wr * 64 + fr, col0 = u.pn * BM + wc * 32 + 4 * fq;
        const int b = epi_batch(rbase);
        const float* src = rbase < 16384 ? srcA : srcB - (size_t)16384 * 1024;
        const float* g = gate + (size_t)b * 6144 + col0;
        f32x4 gv[2][2], gpv[2][2];
#pragma unroll
        for (int bj = 0; bj < 2; ++bj)
#pragma unroll
            for (int n = 0; n < 2; ++n) { gv[bj][n] = *(const f32x4*)(g + bj * HALF + n * 16); if (FUSE) gpv[bj][n] = *(const f32x4*)(gpn + (size_t)b * 1024 + col0 + bj * HALF + n * 16); }
#pragma unroll
        for (int ai = 0; ai < 2; ++ai)
#pragma unroll
            for (int m = 0; m < 4; ++m) { const int row = row0 + ai * HALF + m * 16; const size_t off = (size_t)row * 1024 + col0; float s2 = 0.f;
#pragma unroll
                for (int bj = 0; bj < 2; ++bj)
#pragma unroll
                    for (int n = 0; n < 2; ++n) { const f32x4 s = *(const f32x4*)(src + off + bj * HALF + n * 16); const f32x4 o = s + gv[bj][n] * acc[ai][bj][m][n]; *(f32x4*)(out + off + bj * HALF + n * 16) = o;
                        if (FUSE) { s2 += (o[0] * o[0] + o[1] * o[1]) + (o[2] * o[2] + o[3] * o[3]); const f32x4 y = o * gpv[bj][n];
                            unsigned long long w = (unsigned long long)cvt_pk_bf16(y[0], y[1]) | ((unsigned long long)cvt_pk_bf16(y[2], y[3]) << 32); *(unsigned long long*)(xg + off + bj * HALF + n * 16) = w; } }
                if (FUSE) { s2 += __shfl_xor(s2, 16); s2 += __shfl_xor(s2, 32); if (fq == 0) __hip_atomic_fetch_add(ssqn + row, s2, __ATOMIC_RELAXED, __HIP_MEMORY_SCOPE_AGENT); } }
    }
};

template <class Epi, class Sched, bool ALIGN_EPI = false, bool SP2 = false>
__device__ __forceinline__ void gemm_phase(PG8_LAS unsigned char* lds, const Gemm g, const Sched& S, const Epi& E) {
    int tid_ = threadIdx.x; asm volatile("" : "+v"(tid_));
    const int tid = tid_, wid = __builtin_amdgcn_readfirstlane(tid >> 6), lane = tid & 63, wr = wid >> 2, wc = wid & 3, fr = lane & 15, fq = lane >> 4;
    const int K = g.K, nt = K / BK;
    unsigned voffA[2], voffB[2];
#pragma unroll
    for (int i = 0; i < 2; ++i) { int R, C; stage_rc(tid * 16 + i * 8192, R, C); const int Rb = Epi::PERM ? ((R & ~31) + perm32(R & 31)) : R;
        voffA[i] = (unsigned)(R * K + C) * 2u; voffB[i] = (unsigned)(Rb * K + C) * 2u; }
    const size_t kstep = (size_t)(BK * 2);
    const size_t hstep = (size_t)HALF * K * 2;
    const size_t tstep = 2 * hstep;
    const unsigned ldsw = (unsigned)wid * 1024u;
    const int aoff = lds_byte(wr * 64 + fr, fq * 8), boff = lds_byte(wc * 32 + fr, fq * 8);
#define PG8_SA(b, h) (((b) * 2 + (h)) * HTB)
#define PG8_SB(b, h) ((4 + (b) * 2 + (h)) * HTB)
#define PG8_STAGE(bufoff, gbase, voff) do { _Pragma("unroll") for (int _i = 0; _i < 2; ++_i) \
        __builtin_amdgcn_global_load_lds((const unsigned*)((const char*)(gbase) + (voff)[_i]), (PG8_LAS unsigned*)(lds + (bufoff) + ldsw + _i * 8192), 16, 0, 0); } while (0)
#define PG8_LDA(dst, b, h) do { _Pragma("unroll") for (int m = 0; m < 4; ++m) _Pragma("unroll") for (int k = 0; k < 2; ++k) dst[m][k] = *(const PG8_LAS bf16x8*)(lds + PG8_SA(b, h) + aoff + m * 2048 + k * 1024); } while (0)
#define PG8_LDB(dst, b, h) do { _Pragma("unroll") for (int n = 0; n < 2; ++n) _Pragma("unroll") for (int k = 0; k < 2; ++k) dst[n][k] = *(const PG8_LAS bf16x8*)(lds + PG8_SB(b, h) + boff + n * 2048 + k * 1024); } while (0)
#define PG8_MMA(ai, bj, At, Bt) do { __builtin_amdgcn_s_setprio(1); _Pragma("unroll") for (int m = 0; m < 4; ++m) _Pragma("unroll") for (int n = 0; n < 2; ++n) _Pragma("unroll") for (int k = 0; k < 2; ++k) \
        acc[ai][bj][m][n] = __builtin_amdgcn_mfma_f32_16x16x32_bf16(Bt[n][k], At[m][k], acc[ai][bj][m][n], 0, 0, 0); __builtin_amdgcn_s_setprio(0); } while (0)
#define PG8_WAIT_V(n) asm volatile("s_waitcnt vmcnt(" #n ")" ::: "memory")
#define PG8_WAIT_L(n) asm volatile("s_waitcnt lgkmcnt(" #n ")" ::: "memory")
#define PG8_BAR __builtin_amdgcn_s_barrier()
#define PG8_SCHED __builtin_amdgcn_sched_barrier(0)
    Unit cur, nxt; int ui = 0;
    if (!S.next(0, cur)) return;
    f32x4 acc[2][2][4][2];
#pragma unroll
    for (int a = 0; a < 2; ++a)
#pragma unroll
        for (int b = 0; b < 2; ++b)
#pragma unroll
            for (int m = 0; m < 4; ++m)
#pragma unroll
                for (int n = 0; n < 2; ++n) acc[a][b][m][n] = (f32x4){0.f, 0.f, 0.f, 0.f};
    bf16x8 At[4][2], B0[2][2], B1[2][2];
    const char* cA = (const char*)g.A + (size_t)cur.pm * tstep; const char* cB = (const char*)g.Bt + (size_t)cur.pn * tstep;
    S.a_ready(cur);
    if constexpr (SP2) {
        PG8_STAGE(PG8_SB(0, 0), cB, voffB); PG8_STAGE(PG8_SB(0, 1), cB + hstep, voffB); PG8_STAGE(PG8_SA(0, 0), cA, voffA); PG8_STAGE(PG8_SA(0, 1), cA + hstep, voffA);
        if (wr == 1) PG8_BAR;
        PG8_WAIT_V(2); PG8_BAR;
        PG8_STAGE(PG8_SB(1, 0), cB + kstep, voffB); PG8_STAGE(PG8_SA(1, 0), cA + kstep, voffA); PG8_STAGE(PG8_SB(1, 1), cB + hstep + kstep, voffB);
        PG8_WAIT_V(6); PG8_BAR;
    } else {
        PG8_STAGE(PG8_SB(0, 0), cB, voffB); PG8_STAGE(PG8_SA(0, 0), cA, voffA); PG8_STAGE(PG8_SB(0, 1), cB + hstep, voffB); PG8_STAGE(PG8_SA(0, 1), cA + hstep, voffA);
        if (wr == 1) PG8_BAR;
        PG8_WAIT_V(4); PG8_BAR;
        PG8_STAGE(PG8_SB(1, 0), cB + kstep, voffB); PG8_STAGE(PG8_SA(1, 0), cA + kstep, voffA); PG8_STAGE(PG8_SB(1, 1), cB + hstep + kstep, voffB);
        PG8_WAIT_V(6); PG8_BAR;
    }
    for (;;) {
        const bool has_next = S.next(ui + 1, nxt);
        const char* nA = has_next ? (const char*)g.A + (size_t)nxt.pm * tstep : cA; const char* nB = has_next ? (const char*)g.Bt + (size_t)nxt.pn * tstep : cB;
        for (int t = 0; t < nt; t += 2) {
            const bool last = (t == nt - 2);
            const char* a1 = cA + (size_t)(t + 1) * kstep;
            const char* a2 = last ? nA : cA + (size_t)(t + 2) * kstep; const char* b2 = last ? nB : cB + (size_t)(t + 2) * kstep;
            const char* a3 = a2 + kstep; const char* b3 = b2 + kstep;
            if (last && has_next) S.a_ready(nxt);
            if constexpr (SP2) {
            PG8_LDB(B0, 0, 0); PG8_LDB(B1, 0, 1); PG8_SCHED; PG8_LDA(At, 0, 0); PG8_STAGE(PG8_SA(1, 1), a1 + hstep, voffA);
            PG8_WAIT_V(8); PG8_WAIT_L(0); PG8_BAR; PG8_MMA(0, 0, At, B0); PG8_MMA(0, 1, At, B1); PG8_BAR; PG8_SCHED;
            PG8_LDA(At, 0, 1); PG8_STAGE(PG8_SB(0, 0), b2, voffB); PG8_STAGE(PG8_SB(0, 1), b2 + hstep, voffB); PG8_STAGE(PG8_SA(0, 0), a2, voffA);
            PG8_WAIT_V(8); PG8_WAIT_L(0); PG8_BAR; PG8_MMA(1, 0, At, B0); PG8_MMA(1, 1, At, B1); PG8_BAR; PG8_SCHED;
            PG8_LDB(B0, 1, 0); PG8_LDB(B1, 1, 1); PG8_SCHED; PG8_LDA(At, 1, 0); PG8_STAGE(PG8_SA(0, 1), a2 + hstep, voffA);
            PG8_WAIT_V(8); PG8_WAIT_L(0); PG8_BAR; PG8_MMA(0, 0, At, B0); PG8_MMA(0, 1, At, B1); PG8_BAR; PG8_SCHED;
            PG8_LDA(At, 1, 1); PG8_STAGE(PG8_SB(1, 0), b3, voffB); PG8_STAGE(PG8_SB(1, 1), b3 + hstep, voffB); PG8_STAGE(PG8_SA(1, 0), a3, voffA);
            PG8_WAIT_V(8); PG8_WAIT_L(0); PG8_BAR; PG8_MMA(1, 0, At, B0); PG8_MMA(1, 1, At, B1); PG8_BAR; PG8_SCHED;
            } else {
            PG8_LDB(B0, 0, 0); PG8_SCHED; PG8_LDA(At, 0, 0); PG8_STAGE(PG8_SA(1, 1), a1 + hstep, voffA);
            PG8_WAIT_L(8); PG8_BAR; PG8_WAIT_L(0); PG8_MMA(0, 0, At, B0); PG8_BAR; PG8_SCHED;
            PG8_LDB(B1, 0, 1); PG8_STAGE(PG8_SB(0, 0), b2, voffB);
            PG8_BAR; PG8_WAIT_L(0); PG8_MMA(0, 1, At, B1); PG8_BAR;
            PG8_LDA(At, 0, 1); PG8_STAGE(PG8_SA(0, 0), a2, voffA);
            PG8_BAR; PG8_WAIT_L(0); PG8_MMA(1, 0, At, B0); PG8_BAR; PG8_SCHED;
            PG8_STAGE(PG8_SB(0, 1), b2 + hstep, voffB);
            PG8_WAIT_V(6); PG8_BAR; PG8_MMA(1, 1, At, B1); PG8_BAR;
            PG8_LDB(B0, 1, 0); PG8_SCHED; PG8_LDA(At, 1, 0); PG8_STAGE(PG8_SA(0, 1), a2 + hstep, voffA);
            PG8_WAIT_L(8); PG8_BAR; PG8_WAIT_L(0); PG8_MMA(0, 0, At, B0); PG8_BAR; PG8_SCHED;
            PG8_LDB(B1, 1, 1); PG8_STAGE(PG8_SB(1, 0), b3, voffB);
            PG8_BAR; PG8_WAIT_L(0); PG8_MMA(0, 1, At, B1); PG8_BAR;
            PG8_LDA(At, 1, 1); PG8_STAGE(PG8_SA(1, 0), a3, voffA);
            PG8_BAR; PG8_WAIT_L(0); PG8_MMA(1, 0, At, B0); PG8_BAR; PG8_SCHED;
            PG8_STAGE(PG8_SB(1, 1), b3 + hstep, voffB);
            PG8_WAIT_V(6); PG8_BAR; PG8_MMA(1, 1, At, B1); PG8_BAR;
            }
        }
        if constexpr (ALIGN_EPI) { if (wr == 0) PG8_BAR; }
        if constexpr (!Epi::AFTER_DRAIN) { E(acc, cur, wr, wc, fr, fq); S.done(cur); }
        if (!has_next) break;
#pragma unroll
        for (int a = 0; a < 2; ++a)
#pragma unroll
            for (int b = 0; b < 2; ++b)
#pragma unroll
                for (int m = 0; m < 4; ++m)
#pragma unroll
                    for (int n = 0; n < 2; ++n) acc[a][b][m][n] = (f32x4){0.f, 0.f, 0.f, 0.f};
        cur = nxt; cA = nA; cB = nB; ++ui;
        if constexpr (ALIGN_EPI) { if (wr == 1) PG8_BAR; }
    }
    PG8_WAIT_V(0);
    if constexpr (!ALIGN_EPI) { if (wr == 0) PG8_BAR; }
    PG8_BAR;
    if constexpr (Epi::AFTER_DRAIN) { E.fused(acc, cur, wr, wc, fr, fq, lds, wid, lane); S.done(cur); }
#undef PG8_SA
#undef PG8_SB
#undef PG8_STAGE
#undef PG8_LDA
#undef PG8_LDB
#undef PG8_MMA
#undef PG8_WAIT_V
#undef PG8_WAIT_L
#undef PG8_BAR
#undef PG8_SCHED
}
}

constexpr int D = 1024, TP = 16384, TS = 32768, T = TP + TS, LP = 4096, LS = 16384, NB = 6, DFF = 2816;
constexpr int EVEN_IN = 2048, ODD_IN = 2304;
constexpr float EPS = 1e-6f, LOG2E = 1.4426950408889634f;
constexpr int NWAVES = 8;
constexpr size_t MiB = 1u << 20;
constexpr size_t WS_MOD = 0;
constexpr size_t WS_CTL = 512 * 1024;
constexpr size_t WS_COS = 1 * MiB, WS_SIN = 3 * MiB;
constexpr size_t WS_WINE = 6 * MiB;
constexpr size_t WS_WOE = 10 * MiB;
constexpr size_t WS_WINO = 12 * MiB;
constexpr size_t WS_WOO = 17 * MiB;
constexpr size_t WS_W13 = 19 * MiB;
constexpr size_t WS_W2 = 41 * MiB;
constexpr size_t WS_PW = 52 * MiB;
constexpr size_t WS_HA = 54 * MiB;
constexpr size_t WS_ZR = 150 * MiB;
constexpr size_t WS_H2 = 414 * MiB;
constexpr size_t WS_END = 510 * MiB;
constexpr size_t WS_GP = 640 * 1024;
constexpr size_t WS_SWIN = 5 * MiB;
constexpr size_t WS_SWUP = 5 * MiB + 128 * 1024;
constexpr size_t WS_S = 53 * MiB;
constexpr int LDS_BYTES = 147456;

#define LAS __attribute__((address_space(3)))
typedef unsigned short bf16;
typedef unsigned v4u __attribute__((ext_vector_type(4)));
typedef unsigned v2u __attribute__((ext_vector_type(2)));
typedef float f32x4 __attribute__((ext_vector_type(4)));
typedef float f32x16 __attribute__((ext_vector_type(16)));
typedef short bf16x8 __attribute__((ext_vector_type(8)));
typedef short s16x4 __attribute__((ext_vector_type(4)));
#define LDS_WAIT() asm volatile("s_waitcnt lgkmcnt(0)" ::: "memory")
__device__ __forceinline__ unsigned f2bf(float f) { unsigned u = __builtin_bit_cast(unsigned, f); return (u + 0x7fffu + ((u >> 16) & 1u)) >> 16; }
__device__ __forceinline__ unsigned pk2(float lo, float hi) { return f2bf(lo) | (f2bf(hi) << 16); }
__device__ __forceinline__ float bflo(unsigned w) { return __builtin_bit_cast(float, w << 16); }
__device__ __forceinline__ float bfhi(unsigned w) { return __builtin_bit_cast(float, w & 0xffff0000u); }
__device__ __forceinline__ float wave_sum(float v) {
#pragma unroll
    for (int o = 1; o < 64; o <<= 1) v += __shfl_xor(v, o);
    return v;
}
__device__ __forceinline__ int crow(int r, int hi) { return (r & 3) + 8 * (r >> 2) + 4 * hi; }

struct Args {
    const float *x_p, *x_s, *c_p, *c_s, *ada_w, *ada_b, *norm_g, *final_g, *w1, *w3, *w2, *even_w_in, *rpb, *pool_w, *pool_scale, *even_w_out,
                *odd_w_in, *sink, *conv_w, *conv_b, *odd_w_out;
    float* out; unsigned char* ws;
};

template <class RowMap>
__device__ __forceinline__ void p0_transpose_item(const float* W, int K, int N, bf16* WT, LAS float* scr, int item, int lane, RowMap rowmap) {
    const int nblk = N / 32, kb = item / nblk, nb = item % nblk, k0 = 64 * kb, n0 = 32 * nb;
#pragma unroll 8
    for (int i = 0; i < 32; ++i) { const int kk = 2 * i + (lane >> 5); scr[kk * 33 + (lane & 31)] = W[(size_t)(k0 + kk) * N + n0 + (lane & 31)]; }
    LDS_WAIT(); asm volatile("" ::: "memory");
    const int c = lane & 7;
#pragma unroll
    for (int j = 0; j < 4; ++j) { const int n = (lane >> 3) + 8 * j; const LAS float* s = scr + (8 * c) * 33 + n;
        v4u o; o.x = pk2(s[0 * 33], s[1 * 33]); o.y = pk2(s[2 * 33], s[3 * 33]); o.z = pk2(s[4 * 33], s[5 * 33]); o.w = pk2(s[6 * 33], s[7 * 33]);
        *(v4u*)(WT + (size_t)rowmap(n0 + n) * K + k0 + 8 * c) = o; }
    LDS_WAIT(); asm volatile("" ::: "memory");
}
struct MapId { __device__ __forceinline__ int operator()(int n) const { return n; } };
struct MapRope { __device__ __forceinline__ int operator()(int n) const { if (n >= 640) return n; const int d = n & 63; return (n & ~63) + ((d & 31) << 1) + (d >> 5); } };
struct MapW1 { __device__ __forceinline__ int operator()(int n) const { return ((n >> 7) << 8) + (n & 127); } };
struct MapW3 { __device__ __forceinline__ int operator()(int n) const { return ((n >> 7) << 8) + 128 + (n & 127); } };

__device__ __forceinline__ int batch_of(int row) { return row < TP ? (row >> 12) : 4 + ((row - TP) >> 14); }

__device__ __forceinline__ void norm_row(const float* xrow, const float* gam, const float* sc, bf16* orow, float* sq, int lane) {
    const f32x4* xr = (const f32x4*)xrow + lane;
    f32x4 v[4]; float s = 0.f;
#pragma unroll
    for (int j = 0; j < 4; ++j) { v[j] = xr[64 * j]; s += (v[j].x * v[j].x + v[j].y * v[j].y) + (v[j].z * v[j].z + v[j].w * v[j].w); }
    s = wave_sum(s); if (lane == 0) *sq = s;
    unsigned long long* o8 = (unsigned long long*)orow + lane;
#pragma unroll
    for (int j = 0; j < 4; ++j) { const f32x4 g = ((const f32x4*)gam)[lane + 64 * j], a = ((const f32x4*)sc)[lane + 64 * j];
        const f32x4 y = v[j] * g * (a + 1.0f);
        o8[64 * j] = (unsigned long long)pk2(y.x, y.y) | ((unsigned long long)pk2(y.z, y.w) << 32); }
}
__device__ __forceinline__ void p1_phase(const Args& A, LAS unsigned char* lds, int tid, int lane, int wave, int G) {
    const float* mod = (const float*)(A.ws + WS_MOD);
    float* GP = (float*)(A.ws + WS_GP);
    for (int i = blockIdx.x * NWAVES * 64 + tid; i < 4 * NB * D; i += G * NWAVES * 64) { const int sidx = i / (NB * D), b = (i / D) % NB, k = i & 1023; const int l = sidx >> 1, wh = sidx & 1;
        GP[i] = A.norm_g[sidx * D + k] * (1.0f + mod[((size_t)l * NB + b) * 6144 + wh * 3072 + 1024 + k]); }
    LAS float* shv = (LAS float*)lds;
    LAS float* part = (LAS float*)(lds + 24576);
    float* SWin = (float*)(A.ws + WS_SWIN); float* SWup = (float*)(A.ws + WS_SWUP);
    for (int cb = blockIdx.x; cb < 244; cb += G) {
        const float* W; int N, n0, l, wh, kind; int r = cb;
        if (r < 32) { kind = 0; l = 0; wh = 0; W = A.even_w_in; N = EVEN_IN; n0 = r * 64; }
        else if (r < 68) { r -= 32; kind = 1; l = 1; wh = 0; W = A.odd_w_in; N = ODD_IN; n0 = r * 64; }
        else { r -= 68; const int q = r / 44; l = q >> 1; kind = 2 + (q & 1); wh = 1; W = (kind == 2 ? A.w1 : A.w3) + (size_t)l * D * DFF; N = DFF; n0 = (r % 44) * 64; }
        __syncthreads();
        for (int i = tid; i < NB * D; i += NWAVES * 64) { const int b = i >> 10, k = i & 1023; shv[i] = mod[((size_t)l * NB + b) * 6144 + wh * 3072 + k]; }
        __syncthreads();
        const int n = n0 + lane; const float* w = W + n; float acc[NB] = {0.f, 0.f, 0.f, 0.f, 0.f, 0.f}; const int k0 = wave * 128;
#pragma unroll 16
        for (int k = 0; k < 128; ++k) { const float wv = w[(size_t)(k0 + k) * N];
#pragma unroll
            for (int b = 0; b < NB; ++b) acc[b] += shv[b * D + k0 + k] * wv; }
#pragma unroll
        for (int b = 0; b < NB; ++b) part[(wave * NB + b) * 64 + lane] = acc[b];
        __syncthreads();
        if (wave < NB) { float sm = 0.f;
#pragma unroll
            for (int w8 = 0; w8 < NWAVES; ++w8) sm += part[(w8 * NB + wave) * 64 + lane];
            const int nn = kind == 1 ? MapRope()(n) : (kind == 2 ? MapW1()(n) : (kind == 3 ? MapW3()(n) : n));
            float* dst = kind < 2 ? SWin + ((size_t)l * NB + wave) * ODD_IN : SWup + ((size_t)l * NB + wave) * 5632; dst[nn] = sm; }
    }
    __syncthreads();
    const int gw = blockIdx.x * NWAVES + wave, NGW = G * NWAVES;
    bf16* H = (bf16*)(A.ws + WS_HA); float* S0 = (float*)(A.ws + WS_S);
    for (int m = gw; m < T; m += NGW) {
        const int b = batch_of(m); const float* xrow = m < TP ? A.x_p + (size_t)m * D : A.x_s + (size_t)(m - TP) * D;
        norm_row(xrow, A.norm_g, mod + (size_t)b * 6144 + 1024, H + (size_t)m * D, S0 + m, lane);
    }
}

#define MFMA32(a, b, c) __builtin_amdgcn_mfma_f32_32x32x16_bf16((a), (b), (c), 0, 0, 0)
struct KVFrag { bf16x8 kf[4]; v4u vld[4]; };
__device__ __forceinline__ void flash_load(KVFrag& f, const bf16* Kp, const bf16* Vp, int ldz, int lane) {
    const int r32 = lane & 31, hi = lane >> 5;
#pragma unroll
    for (int ds = 0; ds < 4; ++ds) f.kf[ds] = *(const bf16x8*)(Kp + (size_t)r32 * ldz + 16 * ds + 8 * hi);
#pragma unroll
    for (int i = 0; i < 4; ++i) f.vld[i] = *(const v4u*)(Vp + (size_t)((lane >> 3) + 8 * i) * ldz + (lane & 7) * 8);
    asm volatile("" ::: "memory");
}
template <class SF>
__device__ __forceinline__ void flash_compute(const KVFrag& f, LAS unsigned char* vt, const bf16x8 (&qf)[4], float& m, float& l, f32x16 (&o)[2], int lane, const SF& sf) {
    const int hi = lane >> 5;
    f32x16 p = {};
#pragma unroll
    for (int ds = 0; ds < 4; ++ds) p = MFMA32(f.kf[ds], qf[ds], p);
#pragma unroll
    for (int i = 0; i < 4; ++i) *(LAS v4u*)(vt + ((lane >> 3) + 8 * i) * 128 + (lane & 7) * 16) = f.vld[i];
    float mx = -INFINITY;
#pragma unroll
    for (int r = 0; r < 16; ++r) { p[r] = sf(p[r], r); mx = fmaxf(mx, p[r]); }
    mx = fmaxf(mx, __shfl_xor(mx, 32));
    const float mnew = fmaxf(m, mx);
    if (__builtin_amdgcn_ballot_w64(mnew > m) != 0ull) {
        const float alpha = __builtin_amdgcn_exp2f(m - mnew); l *= alpha;
#pragma unroll
        for (int r = 0; r < 16; ++r) { o[0][r] *= alpha; o[1][r] *= alpha; }
        m = mnew;
    }
    float rs = 0.f;
#pragma unroll
    for (int r = 0; r < 16; ++r) { p[r] = __builtin_amdgcn_exp2f(p[r] - m); rs += p[r]; }
    l += rs;
    bf16x8 pb[2];
#pragma unroll
    for (int s = 0; s < 2; ++s) { v4u w; w.x = pg8::cvt_pk_bf16(p[8 * s], p[8 * s + 1]); w.y = pg8::cvt_pk_bf16(p[8 * s + 2], p[8 * s + 3]); w.z = pg8::cvt_pk_bf16(p[8 * s + 4], p[8 * s + 5]); w.w = pg8::cvt_pk_bf16(p[8 * s + 6], p[8 * s + 7]); pb[s] = __builtin_bit_cast(bf16x8, w); }
    LDS_WAIT();
    const int i16 = lane & 15, q4 = i16 >> 2, p4 = i16 & 3, blk = (lane >> 4) & 1;
#pragma unroll
    for (int dh = 0; dh < 2; ++dh)
#pragma unroll
        for (int s = 0; s < 2; ++s) {
            const LAS unsigned char* a0 = vt + (16 * s + 4 * hi + q4) * 128 + (32 * dh + 16 * blk) * 2 + 8 * p4;
            const s16x4 lo = __builtin_bit_cast(s16x4, __builtin_amdgcn_ds_read_tr16_b64_v4i16((LAS s16x4*)a0));
            const s16x4 hh = __builtin_bit_cast(s16x4, __builtin_amdgcn_ds_read_tr16_b64_v4i16((LAS s16x4*)(a0 + 8 * 128)));
            const bf16x8 vf = __builtin_shufflevector(lo, hh, 0, 1, 2, 3, 4, 5, 6, 7);
            o[dh] = MFMA32(vf, pb[s], o[dh]);
        }
    LDS_WAIT();
}
__device__ __forceinline__ void flash_store(bf16* orow, const f32x16 (&o)[2], float l, int lane) {
    const int hi = lane >> 5; const float inv = 1.0f / (l + __shfl_xor(l, 32));
#pragma unroll
    for (int dh = 0; dh < 2; ++dh)
#pragma unroll
        for (int g = 0; g < 4; ++g) { v2u w; w.x = pk2(o[dh][4 * g] * inv, o[dh][4 * g + 1] * inv); w.y = pk2(o[dh][4 * g + 2] * inv, o[dh][4 * g + 3] * inv);
            *(v2u*)(orow + 32 * dh + 8 * g + 4 * hi) = w; }
}

__device__ __forceinline__ void p0_phase(const Args& A, LAS unsigned char* lds, int tid, int lane, int wave, int G) {
    float* mod = (float*)(A.ws + WS_MOD);
    {
        LAS float* cact = (LAS float*)lds;
        LAS float* part = (LAS float*)(lds + 24576);
        for (int i = tid; i < NB * D; i += NWAVES * 64) { const int b = i >> 10, k = i & 1023; const float c = b < 4 ? A.c_p[b * D + k] : A.c_s[(b - 4) * D + k]; cact[i] = c / (1.0f + __expf(-c)); }
        __syncthreads();
        for (int cb = blockIdx.x; cb < 2 * 6144 / 64; cb += G) {
            const int layer = cb / 96, j = (cb % 96) * 64 + lane; const float* w = A.ada_w + (size_t)layer * D * 6144 + j;
            float acc[NB] = {0.f, 0.f, 0.f, 0.f, 0.f, 0.f};
            const int k0 = wave * 128;
#pragma unroll 16
            for (int k = 0; k < 128; ++k) { const float wv = w[(size_t)(k0 + k) * 6144];
#pragma unroll
                for (int b = 0; b < NB; ++b) acc[b] += cact[b * D + k0 + k] * wv; }
#pragma unroll
            for (int b = 0; b < NB; ++b) part[(wave * NB + b) * 64 + lane] = acc[b];
            __syncthreads();
            if (wave < NB) { float s = A.ada_b[layer * 6144 + j];
#pragma unroll
                for (int w8 = 0; w8 < NWAVES; ++w8) s += part[(w8 * NB + wave) * 64 + lane];
                mod[((size_t)layer * NB + wave) * 6144 + j] = s; }
            __syncthreads();
        }
    }
    const int gw = blockIdx.x * NWAVES + wave, NGW = G * NWAVES;
    { float* S = (float*)(A.ws + WS_S) + T; for (int i = blockIdx.x * NWAVES * 64 + tid; i < 3 * T; i += G * NWAVES * 64) S[i] = 0.f; }
    {
        float* cosT = (float*)(A.ws + WS_COS); float* sinT = (float*)(A.ws + WS_SIN);
        for (int i = blockIdx.x * NWAVES * 64 + tid; i < 16384 * 32; i += G * NWAVES * 64) {
            const int pos = i >> 5, k = i & 31; const float inv = 1.0f / powf(10000.0f, (float)(2 * k) / 64.0f); const float ang = (float)pos * inv;
            double s, c; sincos((double)ang, &s, &c); cosT[i] = (float)c; sinT[i] = (float)s; }
    }
    {
        LAS float* scr = (LAS float*)(lds + 65536 + wave * 8704);
        constexpr int I_WINE = 16 * 64, I_WO = 16 * 32, I_WINO = 16 * 72, I_W1 = 16 * 88, I_W2 = 44 * 32, I_PW = 2 * 4;
        constexpr int NITEMS = I_WINE + 2 * I_WO + I_WINO + 4 * I_W1 + 2 * I_W2 + 4 * I_PW;
        bf16* ws16 = (bf16*)A.ws;
        for (int it = gw; it < NITEMS; it += NGW) {
            int r = it;
            if (r < I_WINE) { p0_transpose_item(A.even_w_in, D, EVEN_IN, (bf16*)(A.ws + WS_WINE), scr, r, lane, MapId()); continue; } r -= I_WINE;
            if (r < I_WO) { p0_transpose_item(A.even_w_out, D, D, (bf16*)(A.ws + WS_WOE), scr, r, lane, MapId()); continue; } r -= I_WO;
            if (r < I_WO) { p0_transpose_item(A.odd_w_out, D, D, (bf16*)(A.ws + WS_WOO), scr, r, lane, MapId()); continue; } r -= I_WO;
            if (r < I_WINO) { p0_transpose_item(A.odd_w_in, D, ODD_IN, (bf16*)(A.ws + WS_WINO), scr, r, lane, MapRope()); continue; } r -= I_WINO;
            if (r < 2 * I_W1) { const int l = r / I_W1; p0_transpose_item(A.w1 + (size_t)l * D * DFF, D, DFF, (bf16*)(A.ws + WS_W13) + (size_t)l * 5632 * D, scr, r % I_W1, lane, MapW1()); continue; } r -= 2 * I_W1;
            if (r < 2 * I_W1) { const int l = r / I_W1; p0_transpose_item(A.w3 + (size_t)l * D * DFF, D, DFF, (bf16*)(A.ws + WS_W13) + (size_t)l * 5632 * D, scr, r % I_W1, lane, MapW3()); continue; } r -= 2 * I_W1;
            if (r < 2 * I_W2) { const int l = r / I_W2; p0_transpose_item(A.w2 + (size_t)l * DFF * D, DFF, D, (bf16*)(A.ws + WS_W2) + (size_t)l * D * DFF, scr, r % I_W2, lane, MapId()); continue; } r -= 2 * I_W2;
            { const int g = r / I_PW; p0_transpose_item(A.pool_w + (size_t)g * 128 * 128, 128, 128, (bf16*)(A.ws + WS_PW) + (size_t)g * 128 * 128, scr, r % I_PW, lane, MapId()); }
        }
        (void)ws16;
    }
}

struct SfNA { const LAS float* rp; bool rowok; int cq, cs, kc0, hi;
    __device__ __forceinline__ float operator()(float p, int r) const { const int kc = kc0 + crow(r, hi); const bool ok = rowok && (kc >= cs) && (kc < cs + 16); int dc = kc - cq + 15; dc = dc < 0 ? 0 : (dc > 30 ? 30 : dc);
        return ok ? p * (0.125f * LOG2E) + rp[dc] : -INFINITY; } };
__device__ __forceinline__ void even_mixer_phase(const Args& A, LAS unsigned char* lds, int tid, int lane, int wave, int G) {
    const bf16* Z = (const bf16*)(A.ws + WS_ZR); bf16* AO = (bf16*)(A.ws + WS_HA);
    LAS float* rpb = (LAS float*)lds;
    for (int i = tid; i < 8 * 15 * 31; i += NWAVES * 64) rpb[i] = A.rpb[i] * LOG2E;
    __syncthreads();
    LAS unsigned char* vt = lds + 16384 + wave * 4096;
    const int gw = blockIdx.x * NWAVES + wave, NGW = G * NWAVES; const int r32 = lane & 31, hi = lane >> 5;
    constexpr int NTT = T / 32;
#pragma unroll 1
    for (int it = gw; it < NTT * 8; it += NGW) {
        const int hh = it / NTT, tt = it % NTT;
        int sb, rows, rem; if (tt < 512) { sb = (tt >> 7) * LP; rows = 64; rem = tt & 127; } else { const int t2 = tt - 512; sb = TP + (t2 >> 9) * LS; rows = 256; rem = t2 & 511; }
        const int r0 = (rem >> 2) * 2, c0 = (rem & 3) * 16;
        const int rq = r0 + (r32 >> 4), cq = c0 + (r32 & 15); int cs = cq - 8; cs = cs < 0 ? 0 : (cs > 48 ? 48 : cs);
        int rsq = rq - 4; rsq = rsq < 0 ? 0 : (rsq > rows - 8 ? rows - 8 : rsq);
        int rs0 = r0 - 4; rs0 = rs0 < 0 ? 0 : (rs0 > rows - 8 ? rows - 8 : rs0); int rs1 = r0 - 3; rs1 = rs1 < 0 ? 0 : (rs1 > rows - 8 ? rows - 8 : rs1);
        const int nkr = rs1 + 8 - rs0;
        int kc0 = c0 - 8; kc0 = kc0 < 0 ? 0 : (kc0 > 32 ? 32 : kc0);
        const size_t qtok = (size_t)sb + rq * 64 + cq;
        bf16x8 qf[4];
#pragma unroll
        for (int ds = 0; ds < 4; ++ds) qf[ds] = *(const bf16x8*)(Z + qtok * EVEN_IN + hh * 64 + 16 * ds + 8 * hi);
        float m = -1e30f, l = 0.f; f32x16 o[2]; o[0] = f32x16{}; o[1] = f32x16{};
        const bf16* kbase = Z + ((size_t)sb + rs0 * 64 + kc0) * EVEN_IN + 512 + hh * 64;
        KVFrag fa, fb;
        flash_load(fa, kbase, kbase + 512, EVEN_IN, lane);
#pragma unroll 1
        for (int i = 0; i < nkr; i += 2) {
            if (i + 1 < nkr) flash_load(fb, kbase + (size_t)(i + 1) * 64 * EVEN_IN, kbase + (size_t)(i + 1) * 64 * EVEN_IN + 512, EVEN_IN, lane);
            { const int kr = rs0 + i; const bool ok = kr >= rsq && kr < rsq + 8; int dr = kr - rq + 7; dr = dr < 0 ? 0 : (dr > 14 ? 14 : dr);
              SfNA sf{rpb + (hh * 15 + dr) * 31, ok, cq, cs, kc0, hi}; flash_compute(fa, vt, qf, m, l, o, lane, sf); }
            if (i + 1 < nkr) {
                if (i + 2 < nkr) flash_load(fa, kbase + (size_t)(i + 2) * 64 * EVEN_IN, kbase + (size_t)(i + 2) * 64 * EVEN_IN + 512, EVEN_IN, lane);
                const int kr = rs0 + i + 1; const bool ok = kr >= rsq && kr < rsq + 8; int dr = kr - rq + 7; dr = dr < 0 ? 0 : (dr > 14 ? 14 : dr);
                SfNA sf{rpb + (hh * 15 + dr) * 31, ok, cq, cs, kc0, hi}; flash_compute(fb, vt, qf, m, l, o, lane, sf); }
        }
        flash_store(AO + qtok * D + hh * 64, o, l, lane);
    }
    const bf16* PW = (const bf16*)(A.ws + WS_PW);
#pragma unroll 1
    for (int it = gw; it < NTT * 4; it += NGW) {
        const int g = it / NTT, tt = it % NTT, t0 = tt * 32, w = 2 << g, half = w >> 1;
        const int L = t0 < TP ? LP : LS, pos0 = t0 & (L - 1), sb = t0 - pos0, pos = pos0 + r32;
        const int lo = pos - half < 0 ? 0 : pos - half, hiw = pos + half > L ? L : pos + half; const float rc = 1.0f / (float)(hiw - lo);
        const bf16* ub = Z + 1536 + g * 128 + 8 * hi;
        float sm[8][8];
#pragma unroll
        for (int ks = 0; ks < 8; ++ks)
#pragma unroll
            for (int e = 0; e < 8; ++e) sm[ks][e] = 0.f;
#pragma unroll 2
        for (int j = 0; j < w; ++j) { int tp = pos - half + j; const float wt = (tp >= 0 && tp < L) ? 1.0f : 0.0f; tp = tp < 0 ? 0 : (tp >= L ? L - 1 : tp);
            const bf16* up = ub + (size_t)(sb + tp) * EVEN_IN;
            v4u v[8];
#pragma unroll
            for (int ks = 0; ks < 8; ++ks) v[ks] = *(const v4u*)(up + 16 * ks);
#pragma unroll
            for (int ks = 0; ks < 8; ++ks) { sm[ks][0] += wt * bflo(v[ks].x); sm[ks][1] += wt * bfhi(v[ks].x); sm[ks][2] += wt * bflo(v[ks].y); sm[ks][3] += wt * bfhi(v[ks].y);
                sm[ks][4] += wt * bflo(v[ks].z); sm[ks][5] += wt * bfhi(v[ks].z); sm[ks][6] += wt * bflo(v[ks].w); sm[ks][7] += wt * bfhi(v[ks].w); } }
        bf16x8 bfr[8];
        { const bf16* up = ub + (size_t)(sb + pos) * EVEN_IN;
#pragma unroll
          for (int ks = 0; ks < 8; ++ks) { const v4u u = *(const v4u*)(up + 16 * ks);
            v4u mx; mx.x = pg8::cvt_pk_bf16(sm[ks][0] * rc - bflo(u.x), sm[ks][1] * rc - bfhi(u.x)); mx.y = pg8::cvt_pk_bf16(sm[ks][2] * rc - bflo(u.y), sm[ks][3] * rc - bfhi(u.y));
            mx.z = pg8::cvt_pk_bf16(sm[ks][4] * rc - bflo(u.z), sm[ks][5] * rc - bfhi(u.z)); mx.w = pg8::cvt_pk_bf16(sm[ks][6] * rc - bflo(u.w), sm[ks][7] * rc - bfhi(u.w));
            bfr[ks] = __builtin_bit_cast(bf16x8, mx); } }
#pragma unroll
        for (int et = 0; et < 4; ++et) { f32x16 acc = {};
#pragma unroll
            for (int ks = 0; ks < 8; ++ks) { const bf16x8 af = *(const bf16x8*)(PW + (size_t)g * 16384 + (size_t)(32 * et + r32) * 128 + 16 * ks + 8 * hi); acc = MFMA32(af, bfr[ks], acc); }
            bf16* orow = AO + (size_t)(t0 + r32) * D + 512 + g * 128 + 32 * et; const float* scl = A.pool_scale + g * 128 + 32 * et;
#pragma unroll
            for (int q = 0; q < 4; ++q) { const f32x4 sv = *(const f32x4*)(scl + 8 * q + 4 * hi); v2u wv; wv.x = pg8::cvt_pk_bf16(acc[4 * q] * sv.x, acc[4 * q + 1] * sv.y); wv.y = pg8::cvt_pk_bf16(acc[4 * q + 2] * sv.z, acc[4 * q + 3] * sv.w);
                *(v2u*)(orow + 8 * q + 4 * hi) = wv; } }
    }
}

struct SfSWA { int mode, qi, hi;
    __device__ __forceinline__ float operator()(float p, int r) const { const int ki = crow(r, hi); const bool ok = mode == 0 || (mode < 0 ? ki >= qi : ki <= qi); return ok ? p * (0.125f * LOG2E) : -INFINITY; } };
__device__ __forceinline__ void odd_mixer_phase(const Args& A, LAS unsigned char* lds, int tid, int lane, int wave, int G) {
    const bf16* Z = (const bf16*)(A.ws + WS_ZR); bf16* AO = (bf16*)(A.ws + WS_HA);
    LAS unsigned char* vt = lds + 16384 + wave * 4096;
    const int gw = blockIdx.x * NWAVES + wave, NGW = G * NWAVES; const int r32 = lane & 31, hi = lane >> 5;
    constexpr int NTT = T / 32;
#pragma unroll 1
    for (int it = gw; it < NTT * 8; it += NGW) {
        const int hq = it / NTT, tt = it % NTT, t0 = tt * 32, kvh = hq >> 2;
        const int L = t0 < TP ? LP : LS, pos0 = t0 & (L - 1), sb = t0 - pos0;
        bf16x8 qf[4];
#pragma unroll
        for (int ds = 0; ds < 4; ++ds) qf[ds] = *(const bf16x8*)(Z + (size_t)(t0 + r32) * ODD_IN + hq * 64 + 16 * ds + 8 * hi);
        float m = A.sink[hq] * LOG2E, l = hi == 0 ? 1.0f : 0.0f; f32x16 o[2]; o[0] = f32x16{}; o[1] = f32x16{};
        int jlo = -(pos0 >> 5); jlo = jlo < -4 ? -4 : jlo; int jhi = (L - 32 - pos0) >> 5; jhi = jhi > 4 ? 4 : jhi;
        const bf16* kbase = Z + ((size_t)sb + pos0) * ODD_IN + 512 + kvh * 64;
        KVFrag fa, fb;
        flash_load(fa, kbase + (ptrdiff_t)jlo * 32 * ODD_IN, kbase + (ptrdiff_t)jlo * 32 * ODD_IN + 128, ODD_IN, lane);
#pragma unroll 1
        for (int jt = jlo; jt <= jhi; jt += 2) {
            if (jt + 1 <= jhi) flash_load(fb, kbase + (ptrdiff_t)(jt + 1) * 32 * ODD_IN, kbase + (ptrdiff_t)(jt + 1) * 32 * ODD_IN + 128, ODD_IN, lane);
            { SfSWA sf{jt == -4 ? -1 : (jt == 4 ? 1 : 0), r32, hi}; flash_compute(fa, vt, qf, m, l, o, lane, sf); }
            if (jt + 1 <= jhi) {
                if (jt + 2 <= jhi) flash_load(fa, kbase + (ptrdiff_t)(jt + 2) * 32 * ODD_IN, kbase + (ptrdiff_t)(jt + 2) * 32 * ODD_IN + 128, ODD_IN, lane);
                SfSWA sf{jt + 1 == 4 ? 1 : 0, r32, hi}; flash_compute(fb, vt, qf, m, l, o, lane, sf); }
        }
        flash_store(AO + (size_t)(t0 + r32) * D + hq * 64, o, l, lane);
    }
    for (size_t i = (size_t)blockIdx.x * NWAVES * 64 + tid; i < (size_t)T * 64; i += (size_t)G * NWAVES * 64) {
        const int t = (int)(i >> 6), c = (int)(i & 63) * 8; const int L = t < TP ? LP : LS, pos = t & (L - 1);
        const bf16* zr = Z + (size_t)t * ODD_IN; const v4u bg = *(const v4u*)(zr + 768 + c);
        float cv[8]; { const f32x4 b0 = *(const f32x4*)(A.conv_b + c), b1 = *(const f32x4*)(A.conv_b + c + 4); cv[0] = b0.x; cv[1] = b0.y; cv[2] = b0.z; cv[3] = b0.w; cv[4] = b1.x; cv[5] = b1.y; cv[6] = b1.z; cv[7] = b1.w; }
#pragma unroll
        for (int j = 0; j < 3; ++j) { const int tp = pos + j - 1; if (tp < 0 || tp >= L) continue;
            const bf16* zp = zr + (ptrdiff_t)(j - 1) * ODD_IN; const v4u cgv = *(const v4u*)(zp + 1280 + c), xv = *(const v4u*)(zp + 1792 + c);
            const f32x4 w0 = *(const f32x4*)(A.conv_w + j * 512 + c), w1 = *(const f32x4*)(A.conv_w + j * 512 + c + 4);
            cv[0] += w0.x * (bflo(cgv.x) * bflo(xv.x)); cv[1] += w0.y * (bfhi(cgv.x) * bfhi(xv.x)); cv[2] += w0.z * (bflo(cgv.y) * bflo(xv.y)); cv[3] += w0.w * (bfhi(cgv.y) * bfhi(xv.y));
            cv[4] += w1.x * (bflo(cgv.z) * bflo(xv.z)); cv[5] += w1.y * (bfhi(cgv.z) * bfhi(xv.z)); cv[6] += w1.z * (bflo(cgv.w) * bflo(xv.w)); cv[7] += w1.w * (bfhi(cgv.w) * bfhi(xv.w)); }
        v4u o; o.x = pk2(bflo(bg.x) * cv[0], bfhi(bg.x) * cv[1]); o.y = pk2(bflo(bg.y) * cv[2], bfhi(bg.y) * cv[3]); o.z = pk2(bflo(bg.z) * cv[4], bfhi(bg.z) * cv[5]); o.w = pk2(bflo(bg.w) * cv[6], bfhi(bg.w) * cv[7]);
        *(v4u*)(AO + (size_t)t * D + 512 + c) = o;
    }
}

#define XB_TMO      128
#define XB_XCNT(j)  (256  + 64 * (j))
#define XB_XSUB(j)  (1280 + 64 * (j))
#define XB_XGEN(j)  (2304 + 64 * (j))
#define XB_TOP      3328
#define XB_TOPGEN   3392
#define XCD_BAR_WORDS 3456
#define XB_SPIN_CAP (1u << 18)

__device__ __forceinline__ unsigned xb_ld(unsigned* p)              { return __hip_atomic_load(p, __ATOMIC_RELAXED, __HIP_MEMORY_SCOPE_AGENT); }
__device__ __forceinline__ unsigned xb_add(unsigned* p, unsigned v) { return __hip_atomic_fetch_add(p, v, __ATOMIC_RELAXED, __HIP_MEMORY_SCOPE_AGENT); }
__device__ __forceinline__ unsigned xb_xcc_id() { return (unsigned)__builtin_amdgcn_s_getreg((3 << 11) | 20) & 0xFu; }
#define XB_SPIN(cond, bar) do { unsigned _sp = 0; while (cond) { __builtin_amdgcn_s_sleep(1); \
    if ((++_sp & 255u) == 0u) { if (xb_ld(&(bar)[XB_TMO])) break; if (_sp > XB_SPIN_CAP) { atomicAdd(&(bar)[XB_TMO], 1u); break; } } } } while (0)

struct XcdBarrier {
    unsigned* bar; unsigned x;
    volatile LAS unsigned* st;
};

__device__ __forceinline__ XcdBarrier xcd_barrier_post(unsigned* bar, volatile LAS unsigned* st) {
    XcdBarrier b; b.bar = bar; b.x = xb_xcc_id(); b.st = st;
    if (threadIdx.x == 0) (void)xb_add(&bar[XB_XCNT(b.x)], 1u);
    return b;
}
__device__ __forceinline__ void xcd_barrier_complete(unsigned* bar, unsigned x, unsigned& nloc, unsigned& nx) {
    const unsigned G = gridDim.x * gridDim.y * gridDim.z;
    unsigned sum, cnt, mine, sp = 0u;
    for (;;) {
        sum = 0u; cnt = 0u; mine = 0u;
#pragma unroll
        for (unsigned j = 0; j < 16; ++j) { const unsigned c = xb_ld(&bar[XB_XCNT(j)]); sum += c; cnt += (c > 0u) ? 1u : 0u; mine = (j == x) ? c : mine; }
        if (sum == G) break;
        __builtin_amdgcn_s_sleep(1);
        if ((++sp & 255u) == 0u) { if (xb_ld(&bar[XB_TMO])) break; if (sp > XB_SPIN_CAP) { atomicAdd(&bar[XB_TMO], 1u); break; } }
    }
    nloc = mine > 0u ? mine : 1u; nx = cnt > 0u ? cnt : 1u;
}

__device__ __forceinline__ void xcd_barrier(const XcdBarrier& b) {
    asm volatile("s_waitcnt vmcnt(0)" ::: "memory");
    __syncthreads();
    if (threadIdx.x == 0) {
        unsigned* bar = b.bar;
        __builtin_amdgcn_s_waitcnt(0);
        unsigned nloc = b.st[0], nx = b.st[1];
        if (nloc == 0u) { xcd_barrier_complete(bar, b.x, nloc, nx); b.st[0] = nloc; b.st[1] = nx; }
        const unsigned old = xb_add(&bar[XB_XSUB(b.x)], 1u);
        const unsigned gen = old / nloc;
        if (old + 1u == (gen + 1u) * nloc) {
            __builtin_amdgcn_fence(__ATOMIC_RELEASE, "agent");
            asm volatile("s_waitcnt vmcnt(0)" ::: "memory");
            const unsigned og = xb_add(&bar[XB_TOP], 1u);
            const unsigned tg = og / nx;
            if (og + 1u == (tg + 1u) * nx) xb_add(&bar[XB_TOPGEN], 1u);
            else XB_SPIN(xb_ld(&bar[XB_TOPGEN]) == tg, bar);
            __builtin_amdgcn_fence(__ATOMIC_ACQUIRE, "agent");
            xb_add(&bar[XB_XGEN(b.x)], 1u);
            asm volatile("s_waitcnt vmcnt(0)" ::: "memory");
        } else {
            XB_SPIN(xb_ld(&bar[XB_XGEN(b.x)]) == gen, bar);
            __builtin_amdgcn_fence(__ATOMIC_ACQUIRE, "agent");
            asm volatile("s_waitcnt vmcnt(0)" ::: "memory");
        }
    }
    __syncthreads();
}

__global__ void __launch_bounds__(NWAVES * 64, 2) hybrid_fwd(Args A) {
    extern __shared__ __attribute__((aligned(16))) unsigned char lds_raw[];
    LAS unsigned char* lds = (LAS unsigned char*)lds_raw;
    cg::grid_group grid = cg::this_grid();
    int tid = threadIdx.x, lane = tid & 63, wave = __builtin_amdgcn_readfirstlane(tid >> 6); const int G = gridDim.x;
    int gw = blockIdx.x * NWAVES + wave; const int NGW = G * NWAVES;
    float* const X = A.out; const float* const mod = (const float*)(A.ws + WS_MOD);
    bf16* const HA = (bf16*)(A.ws + WS_HA); bf16* const ZR = (bf16*)(A.ws + WS_ZR);
    const float* cosT = (const float*)(A.ws + WS_COS); const float* sinT = (const float*)(A.ws + WS_SIN);

#define RELAUNDER() do { int t_ = threadIdx.x; asm volatile("" : "+v"(t_)); tid = t_; lane = tid & 63; wave = __builtin_amdgcn_readfirstlane(tid >> 6); gw = blockIdx.x * NWAVES + wave; } while (0)
    p0_phase(A, lds, tid, lane, wave, G);
    { unsigned* bw = (unsigned*)(A.ws + WS_CTL); if (blockIdx.x == 0) for (int i = threadIdx.x; i < XCD_BAR_WORDS; i += NWAVES * 64) __hip_atomic_store(bw + i, 0u, __ATOMIC_RELAXED, __HIP_MEMORY_SCOPE_AGENT); }
    volatile LAS unsigned* bst = (volatile LAS unsigned*)(lds + 143360);
    if (threadIdx.x < 2) bst[threadIdx.x] = 0u;
    grid.sync();
    const XcdBarrier xbar = xcd_barrier_post((unsigned*)(A.ws + WS_CTL), bst);
    RELAUNDER(); p1_phase(A, lds, tid, lane, wave, G);
    xcd_barrier(xbar);
    float* const SS = (float*)(A.ws + WS_S); const float* const GP = (const float*)(A.ws + WS_GP); bf16* const H2 = (bf16*)(A.ws + WS_H2);
#pragma unroll 1
    for (int layer = 0; layer < 2; ++layer) {
        const float* srcA = layer == 0 ? A.x_p : X; const float* srcB = layer == 0 ? A.x_s : X + (size_t)TP * D;
        {
            const int N = layer == 0 ? EVEN_IN : ODD_IN;
            pg8::Gemm g{HA, (const bf16*)(A.ws + (layer == 0 ? WS_WINE : WS_WINO)), T, N, D}; pg8::StaticOrder S; S.init(T, N, G, (int)blockIdx.x);
            pg8::EpiBf16R E{ZR, N, layer == 0 ? 0 : 640, cosT, sinT, SS + (size_t)(layer * 2) * T, (const float*)(A.ws + WS_SWIN) + (size_t)layer * NB * ODD_IN, ODD_IN};
            pg8::gemm_phase<pg8::EpiBf16R, pg8::StaticOrder, true, true>(lds, g, S, E);
        }
        xcd_barrier(xbar);
        RELAUNDER();
        if (layer == 0) even_mixer_phase(A, lds, tid, lane, wave, G); else odd_mixer_phase(A, lds, tid, lane, wave, G);
        xcd_barrier(xbar);
        {
            pg8::Gemm g{HA, (const bf16*)(A.ws + (layer == 0 ? WS_WOE : WS_WOO)), T, D, D}; pg8::StaticOrder S; S.init(T, D, G, (int)blockIdx.x);
            pg8::EpiRes<true> E{srcA, srcB, X, mod + (size_t)layer * NB * 6144 + 2048, SS + (size_t)(layer * 2 + 1) * T, GP + (size_t)(layer * 2 + 1) * NB * D, H2};
            pg8::gemm_phase<pg8::EpiRes<true>, pg8::StaticOrder, true, true>(lds, g, S, E);
        }
        xcd_barrier(xbar);
        {
            pg8::Gemm g{H2, (const bf16*)(A.ws + WS_W13) + (size_t)layer * 5632 * D, T, 5632, D}; pg8::StaticOrder S; S.init(T, 5632, G, (int)blockIdx.x);
            pg8::EpiSwiGLU E{ZR, DFF, SS + (size_t)(layer * 2 + 1) * T, (const float*)(A.ws + WS_SWUP) + (size_t)layer * NB * 5632};
            pg8::gemm_phase<pg8::EpiSwiGLU, pg8::StaticOrder, true, true>(lds, g, S, E);
        }
        xcd_barrier(xbar);
        {
            pg8::Gemm g{ZR, (const bf16*)(A.ws + WS_W2) + (size_t)layer * D * DFF, T, D, DFF}; pg8::StaticOrder S; S.init(T, D, G, (int)blockIdx.x);
            if (layer == 0) { pg8::EpiRes<true> E{X, X + (size_t)TP * D, X, mod + (size_t)layer * NB * 6144 + 5120, SS + (size_t)2 * T, GP + (size_t)2 * NB * D, HA};
                pg8::gemm_phase<pg8::EpiRes<true>, pg8::StaticOrder, true, true>(lds, g, S, E); }
            else { pg8::EpiRes<false> E{X, X + (size_t)TP * D, X, mod + (size_t)layer * NB * 6144 + 5120, nullptr, nullptr, nullptr};
                pg8::gemm_phase<pg8::EpiRes<false>, pg8::StaticOrder, true, true>(lds, g, S, E); }
        }
        xcd_barrier(xbar);
    }
    RELAUNDER();
    for (int mrow = gw; mrow < T; mrow += NGW) {
        f32x4* xr = (f32x4*)(X + (size_t)mrow * D) + lane; f32x4 v[4]; float s = 0.f;
#pragma unroll
        for (int j = 0; j < 4; ++j) { v[j] = xr[64 * j]; s += (v[j].x * v[j].x + v[j].y * v[j].y) + (v[j].z * v[j].z + v[j].w * v[j].w); }
        const float rstd = 1.f / sqrtf(wave_sum(s) * (1.f / D) + EPS);
#pragma unroll
        for (int j = 0; j < 4; ++j) xr[64 * j] = (v[j] * rstd) * ((const f32x4*)A.final_g)[lane + 64 * j];
    }
}

extern "C" void kernel_launch(void* const* d_in, const int* in_sizes, int n_in, void* d_out, int out_size, void* d_ws, size_t ws_size, hipStream_t stream) {
    static int grid = 0;
    if (grid == 0) {
        if (n_in != 21 || out_size != T * D || ws_size < WS_END) { fprintf(stderr, "kernel_launch: unexpected shapes (n_in %d out %d ws %zu)\n", n_in, out_size, ws_size); grid = -1; return; }
        int dev = 0, cus = 0, per_cu = 0;
        hipGetDevice(&dev); hipDeviceGetAttribute(&cus, hipDeviceAttributeMultiprocessorCount, dev);
        hipFuncSetAttribute((const void*)hybrid_fwd, hipFuncAttributeMaxDynamicSharedMemorySize, LDS_BYTES);
        if (hipOccupancyMaxActiveBlocksPerMultiprocessor(&per_cu, (const void*)hybrid_fwd, NWAVES * 64, LDS_BYTES) != hipSuccess || per_cu < 1) per_cu = 1;
        (void)hipGetLastError();
        grid = cus * per_cu;
    }
    if (grid < 0) return;
    Args a{};
    const float** p = (const float**)&a;
    for (int i = 0; i < 21; ++i) p[i] = (const float*)d_in[i];
    a.out = (float*)d_out; a.ws = (unsigned char*)d_ws;
    void* args[] = {&a};
    hipError_t e = hipLaunchCooperativeKernel((const void*)hybrid_fwd, dim3(grid), dim3(NWAVES * 64), args, LDS_BYTES, stream);
    if (e != hipSuccess) fprintf(stderr, "cooperative launch failed: %s (grid %d)\n", hipGetErrorString(e), grid);
}
```

```cpp
#include <hip/hip_runtime.h>
#include <hip/hip_cooperative_groups.h>
#include <cstdio>
#include <cstdint>
namespace cg = cooperative_groups;
#define TID_TAB_OFF (143360 + 64)
__device__ __forceinline__ int hw_slot() { return (int)(__builtin_amdgcn_s_getreg((5 << 11) | 4) & 63u); }
__device__ __forceinline__ int my_lane() { unsigned z = 0u; asm volatile("" : "+v"(z)); return (int)__builtin_amdgcn_mbcnt_hi(~0u, __builtin_amdgcn_mbcnt_lo(~0u, z)); }
__device__ __forceinline__ int my_tid() {
    extern __shared__ __attribute__((aligned(16))) unsigned char lds_raw[];
    const volatile __attribute__((address_space(3))) int* tab = (const volatile __attribute__((address_space(3))) int*)((__attribute__((address_space(3))) unsigned char*)lds_raw + TID_TAB_OFF);
    const int w = __builtin_amdgcn_readfirstlane(tab[hw_slot()]); return w * 64 + my_lane();
}
namespace pg8 {
#define PG8_LAS __attribute__((address_space(3)))
typedef unsigned short bf16_t;
typedef short bf16x8 __attribute__((ext_vector_type(8)));
typedef float f32x4 __attribute__((ext_vector_type(4)));
typedef unsigned u32x4 __attribute__((ext_vector_type(4)));
constexpr int BM = 256, BK = 64, HALF = 128, HTB = HALF * BK * 2  , STAGE_BYTES = 8 * HTB, NXCD = 8, WGM = 8;

__host__ __device__ __forceinline__ int lds_byte(int r, int c) { const int st = (r >> 4) * 2 + (c >> 5), rr = r & 15, cc = c & 31, ob = rr * 64 + cc * 2; return st * 1024 + (ob ^ (((ob >> 9) & 1) << 5)); }
__host__ __device__ __forceinline__ void stage_rc(int b, int& R, int& C) { const int st = b / 1024, sb = b % 1024, swz = sb ^ (((sb >> 9) & 1) << 5); R = (st >> 1) * 16 + swz / 64; C = (st & 1) * 32 + (swz % 64) / 2; }
__host__ __device__ __forceinline__ int perm32(int rho) { const int n = rho >> 4, i = rho & 15; return 8 * (i >> 2) + 4 * n + (i & 3); }

struct Unit { int pm, pn; };
struct Gemm { const bf16_t* A; const bf16_t* Bt; int M, N, K; };

struct StaticOrder {
    int nM, nN, nwg, G, c;
    __host__ __device__ void init(int M, int N, int G_, int c_) { nM = M / BM; nN = N / BM; nwg = nM * nN; G = G_; c = c_; }
    __host__ __device__ bool next(int i, Unit& u) const {
        const long L = (long)i * G + c; if (L >= nwg) return false;
        int wgid = (int)L; { const int q = nwg / NXCD, r = nwg % NXCD, xcd = wgid % NXCD, off = wgid / NXCD; wgid = (xcd < r ? xcd * (q + 1) : r * (q + 1) + (xcd - r) * q) + off; }
        const int nig = WGM * nN, gid = wgid / nig, fm = gid * WGM, gsz = (nM - fm) < WGM ? (nM - fm) : WGM;
        u.pm = fm + ((wgid % nig) % gsz); u.pn = (wgid % nig) / gsz; return true;
    }
    __device__ __forceinline__ void a_ready(const Unit&) const {}
    __device__ __forceinline__ void done(const Unit&) const {}
};

typedef float f32x2_t __attribute__((ext_vector_type(2))); typedef __bf16 bf16x2_t __attribute__((ext_vector_type(2)));
__device__ __forceinline__ unsigned cvt_pk_bf16(float lo, float hi) { f32x2_t v = {lo, hi}; bf16x2_t b = __builtin_convertvector(v, bf16x2_t); return __builtin_bit_cast(unsigned, b); }

__device__ __forceinline__ int epi_batch(int rbase) { return rbase < 16384 ? (rbase >> 12) : 4 + ((rbase - 16384) >> 14); }
struct EpiBf16R {
    static constexpr bool PERM = true, AFTER_DRAIN = false;
    bf16_t* O; int ldc; int rope_cols; const float* cosT; const float* sinT; const float* ssq; const float* sw; int swld;
    __device__ __forceinline__ void operator()(const f32x4 (&acc)[2][2][4][2], const Unit& u, int wr, int wc, int fr, int fq) const {
        const int row0 = u.pm * BM + wr * 64 + fr; const int col0 = u.pn * BM + wc * 32 + 8 * fq;
        const float* swp = sw + (size_t)epi_batch(u.pm * BM) * swld + col0;
        f32x4 swv[2][2]; float sq[8];
#pragma unroll
        for (int bj = 0; bj < 2; ++bj) { swv[bj][0] = *(const f32x4*)(swp + bj * HALF); swv[bj][1] = *(const f32x4*)(swp + bj * HALF + 4); }
#pragma unroll
        for (int rg = 0; rg < 8; ++rg) sq[rg] = ssq[row0 + (rg >> 2) * HALF + (rg & 3) * 16];
        const bool rope0 = col0 < rope_cols, rope1 = col0 + HALF < rope_cols;
        const int i0 = (col0 & 63) >> 1;
        f32x4 tb[2][2];
#define EPI_TBL(buf, rg) do { const int row_ = row0 + ((rg) >> 2) * HALF + ((rg) & 3) * 16; const size_t po_ = (size_t)(row_ & (row_ < 16384 ? 4095 : 16383)) * 32 + i0; \
            tb[buf][0] = *(const f32x4*)(cosT + po_); tb[buf][1] = *(const f32x4*)(sinT + po_); } while (0)
        if (rope0) EPI_TBL(0, 0);
        asm volatile("" ::: "memory");
#pragma unroll
        for (int rg = 0; rg < 8; ++rg) { const int ai = rg >> 2, m = rg & 3; const int row = row0 + ai * HALF + m * 16; bf16_t* rowp = O + (size_t)row * ldc + col0;
            if (rope0 && rg < 7) { if ((rg & 1) == 0) EPI_TBL(1, rg + 1); else EPI_TBL(0, rg + 1); }
            asm volatile("" ::: "memory");
            const float rstd = __builtin_amdgcn_rsqf(sq[rg] * (1.0f / 1024.0f) + 1e-6f);
#pragma unroll
            for (int bj = 0; bj < 2; ++bj) { f32x4 v0 = acc[ai][bj][m][0] * rstd + swv[bj][0], v1 = acc[ai][bj][m][1] * rstd + swv[bj][1];
                if (bj == 0 ? rope0 : rope1) { const f32x4 cs = tb[rg & 1][0], sn = tb[rg & 1][1];
                    f32x4 w0, w1;
                    w0[0] = v0[0] * cs[0] - v0[1] * sn[0]; w0[1] = v0[0] * sn[0] + v0[1] * cs[0];
                    w0[2] = v0[2] * cs[1] - v0[3] * sn[1]; w0[3] = v0[2] * sn[1] + v0[3] * cs[1];
                    w1[0] = v1[0] * cs[2] - v1[1] * sn[2]; w1[1] = v1[0] * sn[2] + v1[1] * cs[2];
                    w1[2] = v1[2] * cs[3] - v1[3] * sn[3]; w1[3] = v1[2] * sn[3] + v1[3] * cs[3];
                    v0 = w0; v1 = w1; }
                u32x4 w; w.x = cvt_pk_bf16(v0[0], v0[1]); w.y = cvt_pk_bf16(v0[2], v0[3]); w.z = cvt_pk_bf16(v1[0], v1[1]); w.w = cvt_pk_bf16(v1[2], v1[3]);
                *(u32x4*)(rowp + bj * HALF) = w; } }
#undef EPI_TBL
    }
};
__device__ __forceinline__ float silu_f(float x) { return x * __builtin_amdgcn_rcpf(1.0f + __builtin_amdgcn_exp2f(-1.4426950408889634f * x)); }
struct EpiSwiGLU {
    static constexpr bool PERM = true, AFTER_DRAIN = false;
    bf16_t* O; int ldc; const float* ssq; const float* sw;
    __device__ __forceinline__ void operator()(const f32x4 (&acc)[2][2][4][2], const Unit& u, int wr, int wc, int fr, int fq) const {
        const int row0 = u.pm * BM + wr * 64 + fr; const int col0 = u.pn * HALF + wc * 32 + 8 * fq;
        const float* swp = sw + (size_t)epi_batch(u.pm * BM) * 5632 + u.pn * BM + wc * 32 + 8 * fq;
        const f32x4 sg0 = *(const f32x4*)(swp), sg1 = *(const f32x4*)(swp + 4), su0 = *(const f32x4*)(swp + HALF), su1 = *(const f32x4*)(swp + HALF + 4);
        float sq[8];
#pragma unroll
        for (int rg = 0; rg < 8; ++rg) sq[rg] = ssq[row0 + (rg >> 2) * HALF + (rg & 3) * 16];
        asm volatile("" ::: "memory");
#pragma unroll
        for (int rg = 0; rg < 8; ++rg) { const int ai = rg >> 2, m = rg & 3; const int row = row0 + ai * HALF + m * 16; bf16_t* rowp = O + (size_t)row * ldc + col0;
                const float rstd = __builtin_amdgcn_rsqf(sq[rg] * (1.0f / 1024.0f) + 1e-6f);
                const f32x4 g0 = acc[ai][0][m][0] * rstd + sg0, g1 = acc[ai][0][m][1] * rstd + sg1, u0 = acc[ai][1][m][0] * rstd + su0, u1 = acc[ai][1][m][1] * rstd + su1;
                u32x4 w; w.x = cvt_pk_bf16(silu_f(g0[0]) * u0[0], silu_f(g0[1]) * u0[1]); w.y = cvt_pk_bf16(silu_f(g0[2]) * u0[2], silu_f(g0[3]) * u0[3]);
                w.z = cvt_pk_bf16(silu_f(g1[0]) * u1[0], silu_f(g1[1]) * u1[1]); w.w = cvt_pk_bf16(silu_f(g1[2]) * u1[2], silu_f(g1[3]) * u1[3]);
                *(u32x4*)rowp = w; }
    }
};
template <bool FUSE> struct EpiRes {
    static constexpr bool PERM = false, AFTER_DRAIN = false;
    const float* srcA; const float* srcB; float* out; const float* gate;
    float* ssqn; const float* gpn; bf16_t* xg;
    __device__ __forceinline__ void operator()(const f32x4 (&acc)[2][2][4][2], const Unit& u, int wr, int wc, int fr, int fq) const {
        const int rbase = u.pm * BM; const int row0 = rbase + wr * 64 + fr, col0 = u.pn * BM + wc * 32 + 4 * fq;
        const int b = epi_batch(rbase);
        const float* src = rbase < 16384 ? srcA : srcB - (size_t)16384 * 1024;
        const float* g = gate + (size_t)b * 6144 + col0; const float* gp = gpn + (size_t)b * 1024 + col0;
        const unsigned ob0 = (unsigned)(row0 * 1024 + col0) * 4u;
        const char* srcb = (const char*)src; char* outb = (char*)out; char* xgb = (char*)xg;
        f32x4 pre[2][8], gv[2], gpv[2]; float s2[4] = {0.f, 0.f, 0.f, 0.f};
#define EPI_RO(ai, m, co) (ob0 + (unsigned)(((ai) * HALF + (m) * 16) * 1024 + (co)) * 4u)
#define EPI_LD(buf, k) do { const int ai_ = (k) >> 1, cb_ = ((k) & 1) * HALF; \
            _Pragma("unroll") for (int n = 0; n < 2; ++n) { gv[n] = *(const f32x4*)(g + cb_ + n * 16); if (FUSE) gpv[n] = *(const f32x4*)(gp + cb_ + n * 16); } \
            _Pragma("unroll") for (int m = 0; m < 4; ++m) _Pragma("unroll") for (int n = 0; n < 2; ++n) pre[buf][m * 2 + n] = *(const f32x4*)(srcb + EPI_RO(ai_, m, cb_ + n * 16)); } while (0)
        EPI_LD(0, 0);
        asm volatile("" ::: "memory");
#pragma unroll
        for (int k = 0; k < 4; ++k) { const int ai = k >> 1, bj = k & 1, cb = bj * HALF;
#pragma unroll
            for (int m = 0; m < 4; ++m)
#pragma unroll
                for (int n = 0; n < 2; ++n) { const f32x4 o = pre[k & 1][m * 2 + n] + gv[n] * acc[ai][bj][m][n]; pre[k & 1][m * 2 + n] = o;
                    if (FUSE) s2[m] += (o[0] * o[0] + o[1] * o[1]) + (o[2] * o[2] + o[3] * o[3]); }
            const f32x4 gpc0 = gpv[0], gpc1 = gpv[1];
            if (k < 3) { if ((k & 1) == 0) EPI_LD(1, k + 1); else EPI_LD(0, k + 1); }
            asm volatile("" ::: "memory");
#pragma unroll
            for (int m = 0; m < 4; ++m)
#pragma unroll
                for (int n = 0; n < 2; ++n) { const unsigned ob = EPI_RO(ai, m, cb + n * 16); const f32x4 o = pre[k & 1][m * 2 + n];
                    *(f32x4*)(outb + ob) = o;
                    if (FUSE) { const f32x4 y = o * (n == 0 ? gpc0 : gpc1); *(unsigned long long*)(xgb + (ob >> 1)) = (unsigned long long)cvt_pk_bf16(y[0], y[1]) | ((unsigned long long)cvt_pk_bf16(y[2], y[3]) << 32); } }
            if (FUSE && bj == 1) {
#pragma unroll
                for (int m = 0; m < 4; ++m) { float t = s2[m]; s2[m] = 0.f; t += __shfl_xor(t, 16); t += __shfl_xor(t, 32); if (fq == 0) __hip_atomic_fetch_add(ssqn + row0 + ai * HALF + m * 16, t, __ATOMIC_RELAXED, __HIP_MEMORY_SCOPE_AGENT); } }
        }
#undef EPI_LD
#undef EPI_RO
    }
};

template <class Epi, class Sched, bool ALIGN_EPI = false, bool SP2 = false>
__device__ __forceinline__ void gemm_phase(PG8_LAS unsigned char* lds, const Gemm g, const Sched& S, const Epi& E) {
    int tid_ = my_tid(); asm volatile("" : "+v"(tid_));
    const int tid = tid_, wid = __builtin_amdgcn_readfirstlane(tid >> 6), lane = tid & 63, wr = wid >> 2, wc = wid & 3, fr = lane & 15, fq = lane >> 4;
    const int K = g.K, nt = K / BK;
    unsigned voffA[2], voffB[2];
#pragma unroll
    for (int i = 0; i < 2; ++i) { int R, C; stage_rc(tid * 16 + i * 8192, R, C); const int Rb = Epi::PERM ? ((R & ~31) + perm32(R & 31)) : R;
        voffA[i] = (unsigned)(R * K + C) * 2u; voffB[i] = (unsigned)(Rb * K + C) * 2u; }
    const size_t kstep = (size_t)(BK * 2);
    const size_t hstep = (size_t)HALF * K * 2;
    const size_t tstep = 2 * hstep;
    const unsigned ldsw = (unsigned)wid * 1024u;
    const int aoff = lds_byte(wr * 64 + fr, fq * 8), boff = lds_byte(wc * 32 + fr, fq * 8);
#define PG8_SA(b, h) (((b) * 2 + (h)) * HTB)
#define PG8_SB(b, h) ((4 + (b) * 2 + (h)) * HTB)
#define PG8_STAGE(bufoff, gbase, voff) do { _Pragma("unroll") for (int _i = 0; _i < 2; ++_i) \
        __builtin_amdgcn_global_load_lds((const unsigned*)((const char*)(gbase) + (voff)[_i]), (PG8_LAS unsigned*)(lds + (bufoff) + ldsw + _i * 8192), 16, 0, 0); } while (0)
#define PG8_LDA(dst, b, h) do { _Pragma("unroll") for (int m = 0; m < 4; ++m) _Pragma("unroll") for (int k = 0; k < 2; ++k) dst[m][k] = *(const PG8_LAS bf16x8*)(lds + PG8_SA(b, h) + aoff + m * 2048 + k * 1024); } while (0)
#define PG8_LDB(dst, b, h) do { _Pragma("unroll") for (int n = 0; n < 2; ++n) _Pragma("unroll") for (int k = 0; k < 2; ++k) dst[n][k] = *(const PG8_LAS bf16x8*)(lds + PG8_SB(b, h) + boff + n * 2048 + k * 1024); } while (0)
#define PG8_MMA(ai, bj, At, Bt) do { __builtin_amdgcn_s_setprio(1); _Pragma("unroll") for (int m = 0; m < 4; ++m) _Pragma("unroll") for (int n = 0; n < 2; ++n) _Pragma("unroll") for (int k = 0; k < 2; ++k) \
        acc[ai][bj][m][n] = __builtin_amdgcn_mfma_f32_16x16x32_bf16(Bt[n][k], At[m][k], acc[ai][bj][m][n], 0, 0, 0); __builtin_amdgcn_s_setprio(0); } while (0)
#define PG8_WAIT_V(n) asm volatile("s_waitcnt vmcnt(" #n ")" ::: "memory")
#define PG8_WAIT_L(n) asm volatile("s_waitcnt lgkmcnt(" #n ")" ::: "memory")
#define PG8_BAR __builtin_amdgcn_s_barrier()
#define PG8_SCHED __builtin_amdgcn_sched_barrier(0)
    Unit cur, nxt; int ui = 0;
    if (!S.next(0, cur)) return;
    f32x4 acc[2][2][4][2];
#pragma unroll
    for (int a = 0; a < 2; ++a)
#pragma unroll
        for (int b = 0; b < 2; ++b)
#pragma unroll
            for (int m = 0; m < 4; ++m)
#pragma unroll
                for (int n = 0; n < 2; ++n) acc[a][b][m][n] = (f32x4){0.f, 0.f, 0.f, 0.f};
    bf16x8 At[4][2], B0[2][2], B1[2][2];
    const char* cA = (const char*)g.A + (size_t)cur.pm * tstep; const char* cB = (const char*)g.Bt + (size_t)cur.pn * tstep;
    S.a_ready(cur);
    if constexpr (SP2) {
        PG8_STAGE(PG8_SB(0, 0), cB, voffB); PG8_STAGE(PG8_SB(0, 1), cB + hstep, voffB); PG8_STAGE(PG8_SA(0, 0), cA, voffA); PG8_STAGE(PG8_SA(0, 1), cA + hstep, voffA);
        if (wr == 1) PG8_BAR;
        PG8_WAIT_V(2); PG8_BAR;
        PG8_STAGE(PG8_SB(1, 0), cB + kstep, voffB); PG8_STAGE(PG8_SA(1, 0), cA + kstep, voffA); PG8_STAGE(PG8_SB(1, 1), cB + hstep + kstep, voffB);
        PG8_WAIT_V(6); PG8_BAR;
    } else {
        PG8_STAGE(PG8_SB(0, 0), cB, voffB); PG8_STAGE(PG8_SA(0, 0), cA, voffA); PG8_STAGE(PG8_SB(0, 1), cB + hstep, voffB); PG8_STAGE(PG8_SA(0, 1), cA + hstep, voffA);
        if (wr == 1) PG8_BAR;
        PG8_WAIT_V(4); PG8_BAR;
        PG8_STAGE(PG8_SB(1, 0), cB + kstep, voffB); PG8_STAGE(PG8_SA(1, 0), cA + kstep, voffA); PG8_STAGE(PG8_SB(1, 1), cB + hstep + kstep, voffB);
        PG8_WAIT_V(6); PG8_BAR;
    }
    for (;;) {
        const bool has_next = S.next(ui + 1, nxt);
        const char* nA = has_next ? (const char*)g.A + (size_t)nxt.pm * tstep : cA; const char* nB = has_next ? (const char*)g.Bt + (size_t)nxt.pn * tstep : cB;
        for (int t = 0; t < nt; t += 2) {
            const bool last = (t == nt - 2);
            const char* a1 = cA + (size_t)(t + 1) * kstep;
            const char* a2 = last ? nA : cA + (size_t)(t + 2) * kstep; const char* b2 = last ? nB : cB + (size_t)(t + 2) * kstep;
            const char* a3 = a2 + kstep; const char* b3 = b2 + kstep;
            if (last && has_next) S.a_ready(nxt);
            if constexpr (SP2) {
            PG8_LDB(B0, 0, 0); PG8_LDB(B1, 0, 1); PG8_SCHED; PG8_LDA(At, 0, 0); PG8_STAGE(PG8_SA(1, 1), a1 + hstep, voffA);
            PG8_WAIT_V(8); PG8_WAIT_L(0); PG8_BAR; PG8_MMA(0, 0, At, B0); PG8_MMA(0, 1, At, B1); PG8_BAR; PG8_SCHED;
            PG8_LDA(At, 0, 1); PG8_STAGE(PG8_SB(0, 0), b2, voffB); PG8_STAGE(PG8_SB(0, 1), b2 + hstep, voffB); PG8_STAGE(PG8_SA(0, 0), a2, voffA);
            PG8_WAIT_V(8); PG8_WAIT_L(0); PG8_BAR; PG8_MMA(1, 0, At, B0); PG8_MMA(1, 1, At, B1); PG8_BAR; PG8_SCHED;
            PG8_LDB(B0, 1, 0); PG8_LDB(B1, 1, 1); PG8_SCHED; PG8_LDA(At, 1, 0); PG8_STAGE(PG8_SA(0, 1), a2 + hstep, voffA);
            PG8_WAIT_V(8); PG8_WAIT_L(0); PG8_BAR; PG8_MMA(0, 0, At, B0); PG8_MMA(0, 1, At, B1); PG8_BAR; PG8_SCHED;
            PG8_LDA(At, 1, 1); PG8_STAGE(PG8_SB(1, 0), b3, voffB); PG8_STAGE(PG8_SB(1, 1), b3 + hstep, voffB); PG8_STAGE(PG8_SA(1, 0), a3, voffA);
            PG8_WAIT_V(8); PG8_WAIT_L(0); PG8_BAR; PG8_MMA(1, 0, At, B0); PG8_MMA(1, 1, At, B1); PG8_BAR; PG8_SCHED;
            } else {
            PG8_LDB(B0, 0, 0); PG8_SCHED; PG8_LDA(At, 0, 0); PG8_STAGE(PG8_SA(1, 1), a1 + hstep, voffA);
            PG8_WAIT_L(8); PG8_BAR; PG8_WAIT_L(0); PG8_MMA(0, 0, At, B0); PG8_BAR; PG8_SCHED;
            PG8_LDB(B1, 0, 1); PG8_STAGE(PG8_SB(0, 0), b2, voffB);
            PG8_BAR; PG8_WAIT_L(0); PG8_MMA(0, 1, At, B1); PG8_BAR;
            PG8_LDA(At, 0, 1); PG8_STAGE(PG8_SA(0, 0), a2, voffA);
            PG8_BAR; PG8_WAIT_L(0); PG8_MMA(1, 0, At, B0); PG8_BAR; PG8_SCHED;
            PG8_STAGE(PG8_SB(0, 1), b2 + hstep, voffB);
            PG8_WAIT_V(6); PG8_BAR; PG8_MMA(1, 1, At, B1); PG8_BAR;
            PG8_LDB(B0, 1, 0); PG8_SCHED; PG8_LDA(At, 1, 0); PG8_STAGE(PG8_SA(0, 1), a2 + hstep, voffA);
            PG8_WAIT_L(8); PG8_BAR; PG8_WAIT_L(0); PG8_MMA(0, 0, At, B0); PG8_BAR; PG8_SCHED;
            PG8_LDB(B1, 1, 1); PG8_STAGE(PG8_SB(1, 0), b3, voffB);
            PG8_BAR; PG8_WAIT_L(0); PG8_MMA(0, 1, At, B1); PG8_BAR;
            PG8_LDA(At, 1, 1); PG8_STAGE(PG8_SA(1, 0), a3, voffA);
            PG8_BAR; PG8_WAIT_L(0); PG8_MMA(1, 0, At, B0); PG8_BAR; PG8_SCHED;
            PG8_STAGE(PG8_SB(1, 1), b3 + hstep, voffB);
            PG8_WAIT_V(6); PG8_BAR; PG8_MMA(1, 1, At, B1); PG8_BAR;
            }
        }
        if constexpr (ALIGN_EPI) { if (wr == 0) PG8_BAR; }
        if constexpr (!Epi::AFTER_DRAIN) { E(acc, cur, wr, wc, fr, fq); S.done(cur); }
        if (!has_next) break;
#pragma unroll
        for (int a = 0; a < 2; ++a)
#pragma unroll
            for (int b = 0; b < 2; ++b)
#pragma unroll
                for (int m = 0; m < 4; ++m)
#pragma unroll
                    for (int n = 0; n < 2; ++n) acc[a][b][m][n] = (f32x4){0.f, 0.f, 0.f, 0.f};
        cur = nxt; cA = nA; cB = nB; ++ui;
        if constexpr (ALIGN_EPI) { if (wr == 1) PG8_BAR; }
    }
    PG8_WAIT_V(0);
    if constexpr (!ALIGN_EPI) { if (wr == 0) PG8_BAR; }
    PG8_BAR;
    if constexpr (Epi::AFTER_DRAIN) { E.fused(acc, cur, wr, wc, fr, fq, lds, wid, lane); S.done(cur); }
#undef PG8_SA
#undef PG8_SB
#undef PG8_STAGE
#undef PG8_LDA
#undef PG8_LDB
#undef PG8_MMA
#undef PG8_WAIT_V
#undef PG8_WAIT_L
#undef PG8_BAR
#undef PG8_SCHED
}
}

constexpr int D = 1024, TP = 16384, TS = 32768, T = TP + TS, LP = 4096, LS = 16384, NB = 6, DFF = 2816;
constexpr int EVEN_IN = 2048, ODD_IN = 2304;
constexpr float EPS = 1e-6f, LOG2E = 1.4426950408889634f;
constexpr int NWAVES = 8, GRID = 256;
constexpr size_t MiB = 1u << 20;
constexpr size_t WS_MOD = 0;
constexpr size_t WS_CTL = 512 * 1024;
constexpr size_t WS_COS = 1 * MiB, WS_SIN = 3 * MiB;
constexpr size_t WS_WINE = 6 * MiB;
constexpr size_t WS_WOE = 10 * MiB;
constexpr size_t WS_WINO = 12 * MiB;
constexpr size_t WS_WOO = 17 * MiB;
constexpr size_t WS_W13 = 19 * MiB;
constexpr size_t WS_W2 = 41 * MiB;
constexpr size_t WS_PW = 52 * MiB;
constexpr size_t WS_HA = 54 * MiB;
constexpr size_t WS_ZR = 150 * MiB;
constexpr size_t WS_H2 = 414 * MiB;
constexpr size_t WS_END = 510 * MiB;
constexpr size_t WS_GP = 640 * 1024;
constexpr size_t WS_SWIN = 5 * MiB;
constexpr size_t WS_SWUP = 5 * MiB + 128 * 1024;
constexpr size_t WS_S = 53 * MiB;
constexpr int LDS_BYTES = 147456;

#define LAS __attribute__((address_space(3)))
typedef unsigned short bf16;
typedef unsigned v4u __attribute__((ext_vector_type(4)));
typedef unsigned v2u __attribute__((ext_vector_type(2)));
typedef float f32x4 __attribute__((ext_vector_type(4)));
typedef float f32x16 __attribute__((ext_vector_type(16)));
typedef short bf16x8 __attribute__((ext_vector_type(8)));
typedef short s16x4 __attribute__((ext_vector_type(4)));
#define LDS_WAIT() asm volatile("s_waitcnt lgkmcnt(0)" ::: "memory")
__device__ __forceinline__ unsigned f2bf(float f) { unsigned u = __builtin_bit_cast(unsigned, f); return (u + 0x7fffu + ((u >> 16) & 1u)) >> 16; }
__device__ __forceinline__ unsigned pk2(float lo, float hi) { return f2bf(lo) | (f2bf(hi) << 16); }
__device__ __forceinline__ float bflo(unsigned w) { return __builtin_bit_cast(float, w << 16); }
__device__ __forceinline__ float bfhi(unsigned w) { return __builtin_bit_cast(float, w & 0xffff0000u); }
__device__ __forceinline__ float wave_sum(float v) {
#pragma unroll
    for (int o = 1; o < 64; o <<= 1) v += __shfl_xor(v, o);
    return v;
}
__device__ __forceinline__ int crow(int r, int hi) { return (r & 3) + 8 * (r >> 2) + 4 * hi; }

struct Args {
    const float *x_p, *x_s, *c_p, *c_s, *ada_w, *ada_b, *norm_g, *final_g, *w1, *w3, *w2, *even_w_in, *rpb, *pool_w, *pool_scale, *even_w_out,
                *odd_w_in, *sink, *conv_w, *conv_b, *odd_w_out;
    float* out; unsigned char* ws;
};

template <class RowMap>
__device__ __forceinline__ void p0_transpose_item(const float* W, int K, int N, bf16* WT, LAS float* scr, int item, int lane, RowMap rowmap) {
    const int nblk = N / 32, kb = item / nblk, nb = item % nblk, k0 = 64 * kb, n0 = 32 * nb;
#pragma unroll 8
    for (int i = 0; i < 32; ++i) { const int kk = 2 * i + (lane >> 5); scr[kk * 33 + (lane & 31)] = W[(size_t)(k0 + kk) * N + n0 + (lane & 31)]; }
    LDS_WAIT(); asm volatile("" ::: "memory");
    const int c = lane & 7;
#pragma unroll
    for (int j = 0; j < 4; ++j) { const int n = (lane >> 3) + 8 * j; const LAS float* s = scr + (8 * c) * 33 + n;
        v4u o; o.x = pk2(s[0 * 33], s[1 * 33]); o.y = pk2(s[2 * 33], s[3 * 33]); o.z = pk2(s[4 * 33], s[5 * 33]); o.w = pk2(s[6 * 33], s[7 * 33]);
        *(v4u*)(WT + (size_t)rowmap(n0 + n) * K + k0 + 8 * c) = o; }
    LDS_WAIT(); asm volatile("" ::: "memory");
}
struct MapId { __device__ __forceinline__ int operator()(int n) const { return n; } };
struct MapRope { __device__ __forceinline__ int operator()(int n) const { if (n >= 640) return n; const int d = n & 63; return (n & ~63) + ((d & 31) << 1) + (d >> 5); } };
struct MapW1 { __device__ __forceinline__ int operator()(int n) const { return ((n >> 7) << 8) + (n & 127); } };
struct MapW3 { __device__ __forceinline__ int operator()(int n) const { return ((n >> 7) << 8) + 128 + (n & 127); } };

__device__ __forceinline__ int batch_of(int row) { return row < TP ? (row >> 12) : 4 + ((row - TP) >> 14); }

__device__ __forceinline__ void norm_row(const float* xrow, const float* gam, const float* sc, bf16* orow, float* sq, int lane) {
    const f32x4* xr = (const f32x4*)xrow + lane;
    f32x4 v[4]; float s = 0.f;
#pragma unroll
    for (int j = 0; j < 4; ++j) { v[j] = xr[64 * j]; s += (v[j].x * v[j].x + v[j].y * v[j].y) + (v[j].z * v[j].z + v[j].w * v[j].w); }
    s = wave_sum(s); if (lane == 0) *sq = s;
    unsigned long long* o8 = (unsigned long long*)orow + lane;
#pragma unroll
    for (int j = 0; j < 4; ++j) { const f32x4 g = ((const f32x4*)gam)[lane + 64 * j], a = ((const f32x4*)sc)[lane + 64 * j];
        const f32x4 y = v[j] * g * (a + 1.0f);
        o8[64 * j] = (unsigned long long)pk2(y.x, y.y) | ((unsigned long long)pk2(y.z, y.w) << 32); }
}
__device__ __forceinline__ void p1_phase(const Args& A, LAS unsigned char* lds, int tid, int lane, int wave, int G) {
    const float* mod = (const float*)(A.ws + WS_MOD);
    float* GP = (float*)(A.ws + WS_GP);
    for (int i = blockIdx.x * NWAVES * 64 + tid; i < 4 * NB * D; i += G * NWAVES * 64) { const int sidx = i / (NB * D), b = (i / D) % NB, k = i & 1023; const int l = sidx >> 1, wh = sidx & 1;
        GP[i] = A.norm_g[sidx * D + k] * (1.0f + mod[((size_t)l * NB + b) * 6144 + wh * 3072 + 1024 + k]); }
    LAS float* shv = (LAS float*)lds;
    LAS float* part = (LAS float*)(lds + 24576);
    float* SWin = (float*)(A.ws + WS_SWIN); float* SWup = (float*)(A.ws + WS_SWUP);
    for (int cb = blockIdx.x; cb < 244; cb += G) {
        const float* W; int N, n0, l, wh, kind; int r = cb;
        if (r < 32) { kind = 0; l = 0; wh = 0; W = A.even_w_in; N = EVEN_IN; n0 = r * 64; }
        else if (r < 68) { r -= 32; kind = 1; l = 1; wh = 0; W = A.odd_w_in; N = ODD_IN; n0 = r * 64; }
        else { r -= 68; const int q = r / 44; l = q >> 1; kind = 2 + (q & 1); wh = 1; W = (kind == 2 ? A.w1 : A.w3) + (size_t)l * D * DFF; N = DFF; n0 = (r % 44) * 64; }
        __syncthreads();
        for (int i = tid; i < NB * D; i += NWAVES * 64) { const int b = i >> 10, k = i & 1023; shv[i] = mod[((size_t)l * NB + b) * 6144 + wh * 3072 + k]; }
        __syncthreads();
        const int n = n0 + lane; const float* w = W + n; float acc[NB] = {0.f, 0.f, 0.f, 0.f, 0.f, 0.f}; const int k0 = wave * 128;
#pragma unroll 16
        for (int k = 0; k < 128; ++k) { const float wv = w[(size_t)(k0 + k) * N];
#pragma unroll
            for (int b = 0; b < NB; ++b) acc[b] += shv[b * D + k0 + k] * wv; }
#pragma unroll
        for (int b = 0; b < NB; ++b) part[(wave * NB + b) * 64 + lane] = acc[b];
        __syncthreads();
        if (wave < NB) { float sm = 0.f;
#pragma unroll
            for (int w8 = 0; w8 < NWAVES; ++w8) sm += part[(w8 * NB + wave) * 64 + lane];
            const int nn = kind == 1 ? MapRope()(n) : (kind == 2 ? MapW1()(n) : (kind == 3 ? MapW3()(n) : n));
            float* dst = kind < 2 ? SWin + ((size_t)l * NB + wave) * ODD_IN : SWup + ((size_t)l * NB + wave) * 5632; dst[nn] = sm; }
    }
    __syncthreads();
    const int gw = blockIdx.x * NWAVES + wave, NGW = G * NWAVES;
    bf16* H = (bf16*)(A.ws + WS_HA); float* S0 = (float*)(A.ws + WS_S);
    for (int m = gw; m < T; m += NGW) {
        const int b = batch_of(m); const float* xrow = m < TP ? A.x_p + (size_t)m * D : A.x_s + (size_t)(m - TP) * D;
        norm_row(xrow, A.norm_g, mod + (size_t)b * 6144 + 1024, H + (size_t)m * D, S0 + m, lane);
    }
}

#define MFMA32(a, b, c) __builtin_amdgcn_mfma_f32_32x32x16_bf16((a), (b), (c), 0, 0, 0)
struct KVFrag { bf16x8 kf[4]; v4u vld[4]; };
__device__ __forceinline__ void flash_load(KVFrag& f, const bf16* Kp, const bf16* Vp, int ldz, int lane) {
    const int r32 = lane & 31, hi = lane >> 5;
#pragma unroll
    for (int ds = 0; ds < 4; ++ds) f.kf[ds] = *(const bf16x8*)(Kp + (size_t)r32 * ldz + 16 * ds + 8 * hi);
#pragma unroll
    for (int i = 0; i < 4; ++i) f.vld[i] = *(const v4u*)(Vp + (size_t)((lane >> 3) + 8 * i) * ldz + (lane & 7) * 8);
    asm volatile("" ::: "memory");
}
template <class SF>
__device__ __forceinline__ void flash_compute(const KVFrag& f, LAS unsigned char* vt, const bf16x8 (&qf)[4], float& m, float& l, f32x16 (&o)[2], int lane, const SF& sf) {
    const int hi = lane >> 5;
    f32x16 p = {};
#pragma unroll
    for (int ds = 0; ds < 4; ++ds) p = MFMA32(f.kf[ds], qf[ds], p);
#pragma unroll
    for (int i = 0; i < 4; ++i) *(LAS v4u*)(vt + ((lane >> 3) + 8 * i) * 128 + (lane & 7) * 16) = f.vld[i];
    float mx = -INFINITY;
#pragma unroll
    for (int r = 0; r < 16; ++r) { p[r] = sf(p[r], r); mx = fmaxf(mx, p[r]); }
    mx = fmaxf(mx, __shfl_xor(mx, 32));
    const float mnew = fmaxf(m, mx);
    if (__builtin_amdgcn_ballot_w64(mnew > m) != 0ull) {
        const float alpha = __builtin_amdgcn_exp2f(m - mnew); l *= alpha;
#pragma unroll
        for (int r = 0; r < 16; ++r) { o[0][r] *= alpha; o[1][r] *= alpha; }
        m = mnew;
    }
    float rs = 0.f;
#pragma unroll
    for (int r = 0; r < 16; ++r) { p[r] = __builtin_amdgcn_exp2f(p[r] - m); rs += p[r]; }
    l += rs;
    bf16x8 pb[2];
#pragma unroll
    for (int s = 0; s < 2; ++s) { v4u w; w.x = pg8::cvt_pk_bf16(p[8 * s], p[8 * s + 1]); w.y = pg8::cvt_pk_bf16(p[8 * s + 2], p[8 * s + 3]); w.z = pg8::cvt_pk_bf16(p[8 * s + 4], p[8 * s + 5]); w.w = pg8::cvt_pk_bf16(p[8 * s + 6], p[8 * s + 7]); pb[s] = __builtin_bit_cast(bf16x8, w); }
    LDS_WAIT();
    const int i16 = lane & 15, q4 = i16 >> 2, p4 = i16 & 3, blk = (lane >> 4) & 1;
#pragma unroll
    for (int dh = 0; dh < 2; ++dh)
#pragma unroll
        for (int s = 0; s < 2; ++s) {
            const LAS unsigned char* a0 = vt + (16 * s + 4 * hi + q4) * 128 + (32 * dh + 16 * blk) * 2 + 8 * p4;
            const s16x4 lo = __builtin_bit_cast(s16x4, __builtin_amdgcn_ds_read_tr16_b64_v4i16((LAS s16x4*)a0));
            const s16x4 hh = __builtin_bit_cast(s16x4, __builtin_amdgcn_ds_read_tr16_b64_v4i16((LAS s16x4*)(a0 + 8 * 128)));
            const bf16x8 vf = __builtin_shufflevector(lo, hh, 0, 1, 2, 3, 4, 5, 6, 7);
            o[dh] = MFMA32(vf, pb[s], o[dh]);
        }
    LDS_WAIT();
}
struct FState { float m, l; f32x16 o[2]; };
template <class SF>
__device__ __forceinline__ bf16x8 flash_softmax(f32x16& p, FState& st, const SF& sf, bf16x8& pb1) {
    float mx = -INFINITY;
#pragma unroll
    for (int r = 0; r < 16; ++r) { p[r] = sf(p[r], r); mx = fmaxf(mx, p[r]); }
    mx = fmaxf(mx, __shfl_xor(mx, 32));
    const float mnew = fmaxf(st.m, mx);
    if (__builtin_amdgcn_ballot_w64(mnew > st.m) != 0ull) {
        const float alpha = __builtin_amdgcn_exp2f(st.m - mnew); st.l *= alpha;
#pragma unroll
        for (int r = 0; r < 16; ++r) { st.o[0][r] *= alpha; st.o[1][r] *= alpha; }
        st.m = mnew;
    }
    float rs = 0.f;
#pragma unroll
    for (int r = 0; r < 16; ++r) { p[r] = __builtin_amdgcn_exp2f(p[r] - st.m); rs += p[r]; }
    st.l += rs;
    v4u w0, w1;
    w0.x = pg8::cvt_pk_bf16(p[0], p[1]); w0.y = pg8::cvt_pk_bf16(p[2], p[3]); w0.z = pg8::cvt_pk_bf16(p[4], p[5]); w0.w = pg8::cvt_pk_bf16(p[6], p[7]);
    w1.x = pg8::cvt_pk_bf16(p[8], p[9]); w1.y = pg8::cvt_pk_bf16(p[10], p[11]); w1.z = pg8::cvt_pk_bf16(p[12], p[13]); w1.w = pg8::cvt_pk_bf16(p[14], p[15]);
    pb1 = __builtin_bit_cast(bf16x8, w1); return __builtin_bit_cast(bf16x8, w0);
}
template <class SFA, class SFB>
__device__ __forceinline__ void flash_compute2(KVFrag& f, bool has_next, const bf16* nK, const bf16* nV, int ldz, LAS unsigned char* vt, const bf16x8 (&qa)[4], const bf16x8 (&qb)[4],
                                               FState& sa, FState& sb, int lane, const SFA& sfa, const SFB& sfb) {
    const int hi = lane >> 5;
    f32x16 pa = {}, pbv = {};
#pragma unroll
    for (int ds = 0; ds < 4; ++ds) { pa = MFMA32(f.kf[ds], qa[ds], pa); pbv = MFMA32(f.kf[ds], qb[ds], pbv); }
#pragma unroll
    for (int i = 0; i < 4; ++i) *(LAS v4u*)(vt + ((lane >> 3) + 8 * i) * 128 + (lane & 7) * 16) = f.vld[i];
    if (has_next) flash_load(f, nK, nV, ldz, lane);
    bf16x8 a0, a1, b0, b1;
    a0 = flash_softmax(pa, sa, sfa, a1);
    b0 = flash_softmax(pbv, sb, sfb, b1);
    LDS_WAIT();
    const int i16 = lane & 15, q4 = i16 >> 2, p4 = i16 & 3, blk = (lane >> 4) & 1;
#pragma unroll
    for (int dh = 0; dh < 2; ++dh)
#pragma unroll
        for (int s = 0; s < 2; ++s) {
            const LAS unsigned char* a_ = vt + (16 * s + 4 * hi + q4) * 128 + (32 * dh + 16 * blk) * 2 + 8 * p4;
            const s16x4 lo = __builtin_bit_cast(s16x4, __builtin_amdgcn_ds_read_tr16_b64_v4i16((LAS s16x4*)a_));
            const s16x4 hh = __builtin_bit_cast(s16x4, __builtin_amdgcn_ds_read_tr16_b64_v4i16((LAS s16x4*)(a_ + 8 * 128)));
            const bf16x8 vf = __builtin_shufflevector(lo, hh, 0, 1, 2, 3, 4, 5, 6, 7);
            sa.o[dh] = MFMA32(vf, s == 0 ? a0 : a1, sa.o[dh]);
            sb.o[dh] = MFMA32(vf, s == 0 ? b0 : b1, sb.o[dh]);
        }
    LDS_WAIT();
}
__device__ __forceinline__ void flash_store(bf16* orow, const f32x16 (&o)[2], float l, int lane) {
    const int hi = lane >> 5; const float inv = 1.0f / (l + __shfl_xor(l, 32));
#pragma unroll
    for (int dh = 0; dh < 2; ++dh)
#pragma unroll
        for (int g = 0; g < 4; ++g) { v2u w; w.x = pk2(o[dh][4 * g] * inv, o[dh][4 * g + 1] * inv); w.y = pk2(o[dh][4 * g + 2] * inv, o[dh][4 * g + 3] * inv);
            *(v2u*)(orow + 32 * dh + 8 * g + 4 * hi) = w; }
}

__device__ __forceinline__ void p0_phase(const Args& A, LAS unsigned char* lds, int tid, int lane, int wave, int G) {
    float* mod = (float*)(A.ws + WS_MOD);
    {
        LAS float* cact = (LAS float*)lds;
        LAS float* part = (LAS float*)(lds + 24576);
        for (int i = tid; i < NB * D; i += NWAVES * 64) { const int b = i >> 10, k = i & 1023; const float c = b < 4 ? A.c_p[b * D + k] : A.c_s[(b - 4) * D + k]; cact[i] = c / (1.0f + __expf(-c)); }
        __syncthreads();
        for (int cb = blockIdx.x; cb < 2 * 6144 / 64; cb += G) {
            const int layer = cb / 96, j = (cb % 96) * 64 + lane; const float* w = A.ada_w + (size_t)layer * D * 6144 + j;
            float acc[NB] = {0.f, 0.f, 0.f, 0.f, 0.f, 0.f};
            const int k0 = wave * 128;
#pragma unroll 16
            for (int k = 0; k < 128; ++k) { const float wv = w[(size_t)(k0 + k) * 6144];
#pragma unroll
                for (int b = 0; b < NB; ++b) acc[b] += cact[b * D + k0 + k] * wv; }
#pragma unroll
            for (int b = 0; b < NB; ++b) part[(wave * NB + b) * 64 + lane] = acc[b];
            __syncthreads();
            if (wave < NB) { float s = A.ada_b[layer * 6144 + j];
#pragma unroll
                for (int w8 = 0; w8 < NWAVES; ++w8) s += part[(w8 * NB + wave) * 64 + lane];
                mod[((size_t)layer * NB + wave) * 6144 + j] = s; }
            __syncthreads();
        }
    }
    const int gw = blockIdx.x * NWAVES + wave, NGW = G * NWAVES;
    { float* S = (float*)(A.ws + WS_S) + T; for (int i = blockIdx.x * NWAVES * 64 + tid; i < 3 * T; i += G * NWAVES * 64) S[i] = 0.f; }
    {
        float* cosT = (float*)(A.ws + WS_COS); float* sinT = (float*)(A.ws + WS_SIN);
        for (int i = blockIdx.x * NWAVES * 64 + tid; i < 16384 * 32; i += G * NWAVES * 64) {
            const int pos = i >> 5, k = i & 31; const float inv = 1.0f / powf(10000.0f, (float)(2 * k) / 64.0f); const float ang = (float)pos * inv;
            double s, c; sincos((double)ang, &s, &c); cosT[i] = (float)c; sinT[i] = (float)s; }
    }
    {
        LAS float* scr = (LAS float*)(lds + 65536 + wave * 8704);
        constexpr int I_WINE = 16 * 64, I_WO = 16 * 32, I_WINO = 16 * 72, I_W1 = 16 * 88, I_W2 = 44 * 32, I_PW = 2 * 4;
        constexpr int NITEMS = I_WINE + 2 * I_WO + I_WINO + 4 * I_W1 + 2 * I_W2 + 4 * I_PW;
        bf16* ws16 = (bf16*)A.ws;
        for (int it = gw; it < NITEMS; it += NGW) {
            int r = it;
            if (r < I_WINE) { p0_transpose_item(A.even_w_in, D, EVEN_IN, (bf16*)(A.ws + WS_WINE), scr, r, lane, MapId()); continue; } r -= I_WINE;
            if (r < I_WO) { p0_transpose_item(A.even_w_out, D, D, (bf16*)(A.ws + WS_WOE), scr, r, lane, MapId()); continue; } r -= I_WO;
            if (r < I_WO) { p0_transpose_item(A.odd_w_out, D, D, (bf16*)(A.ws + WS_WOO), scr, r, lane, MapId()); continue; } r -= I_WO;
            if (r < I_WINO) { p0_transpose_item(A.odd_w_in, D, ODD_IN, (bf16*)(A.ws + WS_WINO), scr, r, lane, MapRope()); continue; } r -= I_WINO;
            if (r < 2 * I_W1) { const int l = r / I_W1; p0_transpose_item(A.w1 + (size_t)l * D * DFF, D, DFF, (bf16*)(A.ws + WS_W13) + (size_t)l * 5632 * D, scr, r % I_W1, lane, MapW1()); continue; } r -= 2 * I_W1;
            if (r < 2 * I_W1) { const int l = r / I_W1; p0_transpose_item(A.w3 + (size_t)l * D * DFF, D, DFF, (bf16*)(A.ws + WS_W13) + (size_t)l * 5632 * D, scr, r % I_W1, lane, MapW3()); continue; } r -= 2 * I_W1;
            if (r < 2 * I_W2) { const int l = r / I_W2; p0_transpose_item(A.w2 + (size_t)l * DFF * D, DFF, D, (bf16*)(A.ws + WS_W2) + (size_t)l * D * DFF, scr, r % I_W2, lane, MapId()); continue; } r -= 2 * I_W2;
            { const int g = r / I_PW; p0_transpose_item(A.pool_w + (size_t)g * 128 * 128, 128, 128, (bf16*)(A.ws + WS_PW) + (size_t)g * 128 * 128, scr, r % I_PW, lane, MapId()); }
        }
        (void)ws16;
    }
}

struct SfNA { const LAS float* rp; bool rowok; int cq, cs, kc0, hi;
    __device__ __forceinline__ float operator()(float p, int r) const { const int kc = kc0 + crow(r, hi); const bool ok = rowok && (kc >= cs) && (kc < cs + 16); int dc = kc - cq + 15; dc = dc < 0 ? 0 : (dc > 30 ? 30 : dc);
        return ok ? p * (0.125f * LOG2E) + rp[dc] : -INFINITY; } };
__device__ __forceinline__ void even_mixer_phase(const Args& A, LAS unsigned char* lds, int tid, int lane, int wave, int G) {
    const bf16* Z = (const bf16*)(A.ws + WS_ZR); bf16* AO = (bf16*)(A.ws + WS_HA);
    LAS float* rpb = (LAS float*)lds;
    for (int i = tid; i < 8 * 15 * 31; i += NWAVES * 64) rpb[i] = A.rpb[i] * LOG2E;
    __syncthreads();
    LAS unsigned char* vt = lds + 16384 + wave * 4096;
    const int gw = blockIdx.x * NWAVES + wave, NGW = G * NWAVES; const int r32 = lane & 31, hi = lane >> 5;
    constexpr int NTT = T / 32;
    constexpr int NQT = T / 64;
#pragma unroll 1
    for (int it = gw; it < NQT * 8; it += NGW) {
        const int hh = it / NQT, tt = it % NQT;
        int sb, rows, rem; if (tt < 256) { sb = (tt >> 6) * LP; rows = 64; rem = tt & 63; } else { const int t2 = tt - 256; sb = TP + (t2 >> 8) * LS; rows = 256; rem = t2 & 255; }
        const int r0 = (rem >> 2) * 4, c0 = (rem & 3) * 16;
        const int rqa = r0 + (r32 >> 4), rqb = rqa + 2, cq = c0 + (r32 & 15); int cs = cq - 8; cs = cs < 0 ? 0 : (cs > 48 ? 48 : cs);
        int rsa = rqa - 4; rsa = rsa < 0 ? 0 : (rsa > rows - 8 ? rows - 8 : rsa); int rsb = rqb - 4; rsb = rsb < 0 ? 0 : (rsb > rows - 8 ? rows - 8 : rsb);
        int rs0 = r0 - 4; rs0 = rs0 < 0 ? 0 : (rs0 > rows - 8 ? rows - 8 : rs0); int rs3 = r0 - 1; rs3 = rs3 < 0 ? 0 : (rs3 > rows - 8 ? rows - 8 : rs3);
        const int nkr = rs3 + 8 - rs0;
        int kc0 = c0 - 8; kc0 = kc0 < 0 ? 0 : (kc0 > 32 ? 32 : kc0);
        const size_t qta = (size_t)sb + rqa * 64 + cq, qtb = qta + 128;
        bf16x8 qa[4], qb[4];
#pragma unroll
        for (int ds = 0; ds < 4; ++ds) { qa[ds] = *(const bf16x8*)(Z + qta * EVEN_IN + hh * 64 + 16 * ds + 8 * hi); qb[ds] = *(const bf16x8*)(Z + qtb * EVEN_IN + hh * 64 + 16 * ds + 8 * hi); }
        FState sa, sbs; sa.m = -1e30f; sa.l = 0.f; sa.o[0] = f32x16{}; sa.o[1] = f32x16{}; sbs.m = -1e30f; sbs.l = 0.f; sbs.o[0] = f32x16{}; sbs.o[1] = f32x16{};
        const bf16* kbase = Z + ((size_t)sb + rs0 * 64 + kc0) * EVEN_IN + 512 + hh * 64;
        KVFrag f;
        flash_load(f, kbase, kbase + 512, EVEN_IN, lane);
#pragma unroll 1
        for (int i = 0; i < nkr; ++i) {
            const int kr = rs0 + i; const bf16* nk = kbase + (size_t)(i + 1) * 64 * EVEN_IN;
            int dra = kr - rqa + 7; dra = dra < 0 ? 0 : (dra > 14 ? 14 : dra); int drb = kr - rqb + 7; drb = drb < 0 ? 0 : (drb > 14 ? 14 : drb);
            SfNA sfa{rpb + (hh * 15 + dra) * 31, kr >= rsa && kr < rsa + 8, cq, cs, kc0, hi}, sfb{rpb + (hh * 15 + drb) * 31, kr >= rsb && kr < rsb + 8, cq, cs, kc0, hi};
            flash_compute2(f, i + 1 < nkr, nk, nk + 512, EVEN_IN, vt, qa, qb, sa, sbs, lane, sfa, sfb);
        }
        flash_store(AO + qta * D + hh * 64, sa.o, sa.l, lane);
        flash_store(AO + qtb * D + hh * 64, sbs.o, sbs.l, lane);
    }
    const bf16* PW = (const bf16*)(A.ws + WS_PW);
#pragma unroll 1
    for (int it = gw; it < NTT * 4; it += NGW) {
        const int g = it / NTT, tt = it % NTT, t0 = tt * 32, w = 2 << g, half = w >> 1;
        const int L = t0 < TP ? LP : LS, pos0 = t0 & (L - 1), sb = t0 - pos0, pos = pos0 + r32;
        const int lo = pos - half < 0 ? 0 : pos - half, hiw = pos + half > L ? L : pos + half; const float rc = 1.0f / (float)(hiw - lo);
        const bf16* ub = Z + 1536 + g * 128 + 8 * hi;
        float sm[8][8];
#pragma unroll
        for (int ks = 0; ks < 8; ++ks)
#pragma unroll
            for (int e = 0; e < 8; ++e) sm[ks][e] = 0.f;
#pragma unroll 2
        for (int j = 0; j < w; ++j) { int tp = pos - half + j; const float wt = (tp >= 0 && tp < L) ? 1.0f : 0.0f; tp = tp < 0 ? 0 : (tp >= L ? L - 1 : tp);
            const bf16* up = ub + (size_t)(sb + tp) * EVEN_IN;
            v4u v[8];
#pragma unroll
            for (int ks = 0; ks < 8; ++ks) v[ks] = *(const v4u*)(up + 16 * ks);
#pragma unroll
            for (int ks = 0; ks < 8; ++ks) { sm[ks][0] += wt * bflo(v[ks].x); sm[ks][1] += wt * bfhi(v[ks].x); sm[ks][2] += wt * bflo(v[ks].y); sm[ks][3] += wt * bfhi(v[ks].y);
                sm[ks][4] += wt * bflo(v[ks].z); sm[ks][5] += wt * bfhi(v[ks].z); sm[ks][6] += wt * bflo(v[ks].w); sm[ks][7] += wt * bfhi(v[ks].w); } }
        bf16x8 bfr[8];
        { const bf16* up = ub + (size_t)(sb + pos) * EVEN_IN;
#pragma unroll
          for (int ks = 0; ks < 8; ++ks) { const v4u u = *(const v4u*)(up + 16 * ks);
            v4u mx; mx.x = pg8::cvt_pk_bf16(sm[ks][0] * rc - bflo(u.x), sm[ks][1] * rc - bfhi(u.x)); mx.y = pg8::cvt_pk_bf16(sm[ks][2] * rc - bflo(u.y), sm[ks][3] * rc - bfhi(u.y));
            mx.z = pg8::cvt_pk_bf16(sm[ks][4] * rc - bflo(u.z), sm[ks][5] * rc - bfhi(u.z)); mx.w = pg8::cvt_pk_bf16(sm[ks][6] * rc - bflo(u.w), sm[ks][7] * rc - bfhi(u.w));
            bfr[ks] = __builtin_bit_cast(bf16x8, mx); } }
#pragma unroll
        for (int et = 0; et < 4; ++et) { f32x16 acc = {};
#pragma unroll
            for (int ks = 0; ks < 8; ++ks) { const bf16x8 af = *(const bf16x8*)(PW + (size_t)g * 16384 + (size_t)(32 * et + r32) * 128 + 16 * ks + 8 * hi); acc = MFMA32(af, bfr[ks], acc); }
            bf16* orow = AO + (size_t)(t0 + r32) * D + 512 + g * 128 + 32 * et; const float* scl = A.pool_scale + g * 128 + 32 * et;
#pragma unroll
            for (int q = 0; q < 4; ++q) { const f32x4 sv = *(const f32x4*)(scl + 8 * q + 4 * hi); v2u wv; wv.x = pg8::cvt_pk_bf16(acc[4 * q] * sv.x, acc[4 * q + 1] * sv.y); wv.y = pg8::cvt_pk_bf16(acc[4 * q + 2] * sv.z, acc[4 * q + 3] * sv.w);
                *(v2u*)(orow + 8 * q + 4 * hi) = wv; } }
    }
}

struct SfSWA { int mode, qi, hi;
    __device__ __forceinline__ float operator()(float p, int r) const { const int ki = crow(r, hi); const bool ok = mode == 0 || (mode < 0 ? ki >= qi : ki <= qi); return ok ? p * (0.125f * LOG2E) : -INFINITY; } };
__device__ __forceinline__ void odd_mixer_phase(const Args& A, LAS unsigned char* lds, int tid, int lane, int wave, int G) {
    const bf16* Z = (const bf16*)(A.ws + WS_ZR); bf16* AO = (bf16*)(A.ws + WS_HA);
    LAS unsigned char* vt = lds + 16384 + wave * 4096;
    const int gw = blockIdx.x * NWAVES + wave, NGW = G * NWAVES; const int r32 = lane & 31, hi = lane >> 5;
    constexpr int NTT = T / 32;
#pragma unroll 1
    for (int it = gw; it < NTT * 4; it += NGW) {
        const int hp = it / NTT, tt = it % NTT, t0 = tt * 32, hq = hp * 2, kvh = hp >> 1;
        const int L = t0 < TP ? LP : LS, pos0 = t0 & (L - 1), sb = t0 - pos0;
        bf16x8 qa[4], qb[4];
#pragma unroll
        for (int ds = 0; ds < 4; ++ds) { qa[ds] = *(const bf16x8*)(Z + (size_t)(t0 + r32) * ODD_IN + hq * 64 + 16 * ds + 8 * hi); qb[ds] = *(const bf16x8*)(Z + (size_t)(t0 + r32) * ODD_IN + hq * 64 + 64 + 16 * ds + 8 * hi); }
        FState sa, sbs; sa.m = A.sink[hq] * LOG2E; sa.l = hi == 0 ? 1.0f : 0.0f; sa.o[0] = f32x16{}; sa.o[1] = f32x16{};
        sbs.m = A.sink[hq + 1] * LOG2E; sbs.l = hi == 0 ? 1.0f : 0.0f; sbs.o[0] = f32x16{}; sbs.o[1] = f32x16{};
        int jlo = -(pos0 >> 5); jlo = jlo < -4 ? -4 : jlo; int jhi = (L - 32 - pos0) >> 5; jhi = jhi > 4 ? 4 : jhi;
        const bf16* kbase = Z + ((size_t)sb + pos0) * ODD_IN + 512 + kvh * 64;
        KVFrag f;
        flash_load(f, kbase + (ptrdiff_t)jlo * 32 * ODD_IN, kbase + (ptrdiff_t)jlo * 32 * ODD_IN + 128, ODD_IN, lane);
#pragma unroll 1
        for (int jt = jlo; jt <= jhi; ++jt) {
            const bf16* nk = kbase + (ptrdiff_t)(jt + 1) * 32 * ODD_IN;
            SfSWA sf{jt == -4 ? -1 : (jt == 4 ? 1 : 0), r32, hi};
            flash_compute2(f, jt < jhi, nk, nk + 128, ODD_IN, vt, qa, qb, sa, sbs, lane, sf, sf);
        }
        flash_store(AO + (size_t)(t0 + r32) * D + hq * 64, sa.o, sa.l, lane);
        flash_store(AO + (size_t)(t0 + r32) * D + hq * 64 + 64, sbs.o, sbs.l, lane);
    }
    {
        const int c = (tid & 63) * 8;
        float wt[3][8], bs[8];
#pragma unroll
        for (int j = 0; j < 3; ++j) { const f32x4 w0 = *(const f32x4*)(A.conv_w + j * 512 + c), w1 = *(const f32x4*)(A.conv_w + j * 512 + c + 4);
            wt[j][0] = w0.x; wt[j][1] = w0.y; wt[j][2] = w0.z; wt[j][3] = w0.w; wt[j][4] = w1.x; wt[j][5] = w1.y; wt[j][6] = w1.z; wt[j][7] = w1.w; }
        { const f32x4 b0 = *(const f32x4*)(A.conv_b + c), b1 = *(const f32x4*)(A.conv_b + c + 4); bs[0] = b0.x; bs[1] = b0.y; bs[2] = b0.z; bs[3] = b0.w; bs[4] = b1.x; bs[5] = b1.y; bs[6] = b1.z; bs[7] = b1.w; }
        const int tstride = (G * NWAVES * 64) >> 6;
#pragma unroll 2
        for (int t = (blockIdx.x * NWAVES * 64 + tid) >> 6; t < T; t += tstride) {
            const int L = t < TP ? LP : LS, pos = t & (L - 1);
            const bf16* zr = Z + (size_t)t * ODD_IN + c; const v4u bg = *(const v4u*)(zr + 768);
            const int dm = pos > 0 ? -1 : 0, dp = pos < L - 1 ? 1 : 0; const float fm = pos > 0 ? 1.f : 0.f, fp = pos < L - 1 ? 1.f : 0.f;
            const v4u cg0 = *(const v4u*)(zr + (ptrdiff_t)dm * ODD_IN + 1280), x0 = *(const v4u*)(zr + (ptrdiff_t)dm * ODD_IN + 1792);
            const v4u cg1 = *(const v4u*)(zr + 1280), x1 = *(const v4u*)(zr + 1792);
            const v4u cg2 = *(const v4u*)(zr + (ptrdiff_t)dp * ODD_IN + 1280), x2 = *(const v4u*)(zr + (ptrdiff_t)dp * ODD_IN + 1792);
            float cv[8];
#define CONV_E(e, lohi, comp) cv[e] = bs[e] + fm * wt[0][e] * (lohi(cg0.comp) * lohi(x0.comp)) + wt[1][e] * (lohi(cg1.comp) * lohi(x1.comp)) + fp * wt[2][e] * (lohi(cg2.comp) * lohi(x2.comp))
            CONV_E(0, bflo, x); CONV_E(1, bfhi, x); CONV_E(2, bflo, y); CONV_E(3, bfhi, y); CONV_E(4, bflo, z); CONV_E(5, bfhi, z); CONV_E(6, bflo, w); CONV_E(7, bfhi, w);
#undef CONV_E
            v4u o; o.x = pg8::cvt_pk_bf16(bflo(bg.x) * cv[0], bfhi(bg.x) * cv[1]); o.y = pg8::cvt_pk_bf16(bflo(bg.y) * cv[2], bfhi(bg.y) * cv[3]);
            o.z = pg8::cvt_pk_bf16(bflo(bg.z) * cv[4], bfhi(bg.z) * cv[5]); o.w = pg8::cvt_pk_bf16(bflo(bg.w) * cv[6], bfhi(bg.w) * cv[7]);
            *(v4u*)(AO + (size_t)t * D + 512 + c) = o;
        }
    }
}

#define XB_TMO      128
#define XB_XCNT(j)  (256  + 64 * (j))
#define XB_XSUB(j)  (1280 + 64 * (j))
#define XB_XGEN(j)  (2304 + 64 * (j))
#define XB_TOP      3328
#define XB_TOPGEN   3392
#define XCD_BAR_WORDS 3456
#define XB_SPIN_CAP (1u << 18)

__device__ __forceinline__ unsigned xb_ld(unsigned* p)              { return __hip_atomic_load(p, __ATOMIC_RELAXED, __HIP_MEMORY_SCOPE_AGENT); }
__device__ __forceinline__ unsigned xb_add(unsigned* p, unsigned v) { return __hip_atomic_fetch_add(p, v, __ATOMIC_RELAXED, __HIP_MEMORY_SCOPE_AGENT); }
__device__ __forceinline__ unsigned xb_xcc_id() { return (unsigned)__builtin_amdgcn_s_getreg((3 << 11) | 20) & 0xFu; }
#define XB_SPIN(cond, bar) do { unsigned _sp = 0; while (cond) { __builtin_amdgcn_s_sleep(1); \
    if ((++_sp & 255u) == 0u) { if (xb_ld(&(bar)[XB_TMO])) break; if (_sp > XB_SPIN_CAP) { atomicAdd(&(bar)[XB_TMO], 1u); break; } } } } while (0)

struct XcdBarrier {
    unsigned* bar; unsigned x;
    volatile LAS unsigned* st;
};

__device__ __forceinline__ XcdBarrier xcd_barrier_post(unsigned* bar, volatile LAS unsigned* st) {
    XcdBarrier b; b.bar = bar; b.x = xb_xcc_id(); b.st = st;
    if (my_tid() == 0) (void)xb_add(&bar[XB_XCNT(b.x)], 1u);
    return b;
}
__device__ __forceinline__ void xcd_barrier_complete(unsigned* bar, unsigned x, unsigned& nloc, unsigned& nx) {
    const unsigned G = gridDim.x * gridDim.y * gridDim.z;
    unsigned sum, cnt, mine, sp = 0u;
    for (;;) {
        sum = 0u; cnt = 0u; mine = 0u;
#pragma unroll
        for (unsigned j = 0; j < 16; ++j) { const unsigned c = xb_ld(&bar[XB_XCNT(j)]); sum += c; cnt += (c > 0u) ? 1u : 0u; mine = (j == x) ? c : mine; }
        if (sum == G) break;
        __builtin_amdgcn_s_sleep(1);
        if ((++sp & 255u) == 0u) { if (xb_ld(&bar[XB_TMO])) break; if (sp > XB_SPIN_CAP) { atomicAdd(&bar[XB_TMO], 1u); break; } }
    }
    nloc = mine > 0u ? mine : 1u; nx = cnt > 0u ? cnt : 1u;
}

__device__ __forceinline__ void xcd_barrier(const XcdBarrier& b) {
    asm volatile("s_waitcnt vmcnt(0)" ::: "memory");
    __syncthreads();
    if (my_tid() == 0) {
        unsigned* bar = b.bar;
        __builtin_amdgcn_s_waitcnt(0);
        unsigned nloc = b.st[0], nx = b.st[1];
        if (nloc == 0u) { xcd_barrier_complete(bar, b.x, nloc, nx); b.st[0] = nloc; b.st[1] = nx; }
        const unsigned old = xb_add(&bar[XB_XSUB(b.x)], 1u);
        const unsigned gen = old / nloc;
        if (old + 1u == (gen + 1u) * nloc) {
            __builtin_amdgcn_fence(__ATOMIC_RELEASE, "agent");
            asm volatile("s_waitcnt vmcnt(0)" ::: "memory");
            const unsigned og = xb_add(&bar[XB_TOP], 1u);
            const unsigned tg = og / nx;
            if (og + 1u == (tg + 1u) * nx) xb_add(&bar[XB_TOPGEN], 1u);
            else XB_SPIN(xb_ld(&bar[XB_TOPGEN]) == tg, bar);
            __builtin_amdgcn_fence(__ATOMIC_ACQUIRE, "agent");
            xb_add(&bar[XB_XGEN(b.x)], 1u);
            asm volatile("s_waitcnt vmcnt(0)" ::: "memory");
        } else {
            XB_SPIN(xb_ld(&bar[XB_XGEN(b.x)]) == gen, bar);
            __builtin_amdgcn_fence(__ATOMIC_ACQUIRE, "agent");
            asm volatile("s_waitcnt vmcnt(0)" ::: "memory");
        }
    }
    __syncthreads();
}

typedef const __attribute__((address_space(4))) Args* CArgsPtr;
__device__ __forceinline__ CArgsPtr args_ptr() { CArgsPtr p = (CArgsPtr)__builtin_amdgcn_kernarg_segment_ptr(); asm volatile("" : "+s"(p)); return p; }
#if defined(__HIP_DEVICE_COMPILE__)
#define ARGS() Args A; __builtin_memcpy(&A, (const __attribute__((address_space(4))) void*)args_ptr(), sizeof(Args))
#else
#define ARGS() const Args A = Akern
#endif
#define TIDS() int tid = my_tid(); asm volatile("" : "+v"(tid)); const int lane = tid & 63, wave = __builtin_amdgcn_readfirstlane(tid >> 6); (void)lane; (void)wave
#define GRID_BAR() do { CArgsPtr ap_ = args_ptr(); XcdBarrier xb_; xb_.bar = (unsigned*)(ap_->ws + WS_CTL); xb_.x = xb_xcc_id(); xb_.st = (volatile LAS unsigned*)(lds + 143360); xcd_barrier(xb_); } while (0)
__global__ void __launch_bounds__(NWAVES * 64, 2) hybrid_fwd(Args Akern) {
    extern __shared__ __attribute__((aligned(16))) unsigned char lds_raw[];
    LAS unsigned char* lds = (LAS unsigned char*)lds_raw;
    constexpr int G = GRID;
    { const int t0_ = threadIdx.x; if ((t0_ & 63) == 0) ((volatile LAS int*)(lds + TID_TAB_OFF))[hw_slot()] = t0_ >> 6; __syncthreads(); }
    { ARGS(); TIDS(); p0_phase(A, lds, tid, lane, wave, G);
      unsigned* bw = (unsigned*)(A.ws + WS_CTL); if (blockIdx.x == 0) for (int i = tid; i < XCD_BAR_WORDS; i += NWAVES * 64) __hip_atomic_store(bw + i, 0u, __ATOMIC_RELAXED, __HIP_MEMORY_SCOPE_AGENT);
      volatile LAS unsigned* bst = (volatile LAS unsigned*)(lds + 143360);
      if (tid < 2) bst[tid] = 0u;
      cg::this_grid().sync();
      (void)xcd_barrier_post((unsigned*)(A.ws + WS_CTL), bst); }
    { ARGS(); TIDS(); p1_phase(A, lds, tid, lane, wave, G); }
    GRID_BAR();
#pragma unroll 1
    for (int layer = 0; layer < 2; ++layer) {
        {
            ARGS(); const int N = layer == 0 ? EVEN_IN : ODD_IN;
            pg8::Gemm g{(const bf16*)(A.ws + WS_HA), (const bf16*)(A.ws + (layer == 0 ? WS_WINE : WS_WINO)), T, N, D}; pg8::StaticOrder S; S.init(T, N, G, (int)blockIdx.x);
            pg8::EpiBf16R E{(bf16*)(A.ws + WS_ZR), N, layer == 0 ? 0 : 640, (const float*)(A.ws + WS_COS), (const float*)(A.ws + WS_SIN), (const float*)(A.ws + WS_S) + (size_t)(layer * 2) * T, (const float*)(A.ws + WS_SWIN) + (size_t)layer * NB * ODD_IN, ODD_IN};
            pg8::gemm_phase<pg8::EpiBf16R, pg8::StaticOrder, true, true>(lds, g, S, E);
        }
        GRID_BAR();
        { ARGS(); TIDS(); if (layer == 0) even_mixer_phase(A, lds, tid, lane, wave, G); else odd_mixer_phase(A, lds, tid, lane, wave, G); }
        GRID_BAR();
        {
            ARGS(); float* const X = A.out; const float* srcA = layer == 0 ? A.x_p : X; const float* srcB = layer == 0 ? A.x_s : X + (size_t)TP * D;
            pg8::Gemm g{(const bf16*)(A.ws + WS_HA), (const bf16*)(A.ws + (layer == 0 ? WS_WOE : WS_WOO)), T, D, D}; pg8::StaticOrder S; S.init(T, D, G, (int)blockIdx.x);
            pg8::EpiRes<true> E{srcA, srcB, X, (const float*)(A.ws + WS_MOD) + (size_t)layer * NB * 6144 + 2048, (float*)(A.ws + WS_S) + (size_t)(layer * 2 + 1) * T, (const float*)(A.ws + WS_GP) + (size_t)(layer * 2 + 1) * NB * D, (bf16*)(A.ws + WS_H2)};
            pg8::gemm_phase<pg8::EpiRes<true>, pg8::StaticOrder, true, true>(lds, g, S, E);
        }
        GRID_BAR();
        {
            ARGS();
            pg8::Gemm g{(const bf16*)(A.ws + WS_H2), (const bf16*)(A.ws + WS_W13) + (size_t)layer * 5632 * D, T, 5632, D}; pg8::StaticOrder S; S.init(T, 5632, G, (int)blockIdx.x);
            pg8::EpiSwiGLU E{(bf16*)(A.ws + WS_ZR), DFF, (const float*)(A.ws + WS_S) + (size_t)(layer * 2 + 1) * T, (const float*)(A.ws + WS_SWUP) + (size_t)layer * NB * 5632};
            pg8::gemm_phase<pg8::EpiSwiGLU, pg8::StaticOrder, true, true>(lds, g, S, E);
        }
        GRID_BAR();
        {
            ARGS(); float* const X = A.out; const float* gate = (const float*)(A.ws + WS_MOD) + (size_t)layer * NB * 6144 + 5120;
            pg8::Gemm g{(const bf16*)(A.ws + WS_ZR), (const bf16*)(A.ws + WS_W2) + (size_t)layer * D * DFF, T, D, DFF}; pg8::StaticOrder S; S.init(T, D, G, (int)blockIdx.x);
            if (layer == 0) { pg8::EpiRes<true> E{X, X + (size_t)TP * D, X, gate, (float*)(A.ws + WS_S) + (size_t)2 * T, (const float*)(A.ws + WS_GP) + (size_t)2 * NB * D, (bf16*)(A.ws + WS_HA)};
                pg8::gemm_phase<pg8::EpiRes<true>, pg8::StaticOrder, true, true>(lds, g, S, E); }
            else { pg8::EpiRes<false> E{X, X + (size_t)TP * D, X, gate, nullptr, nullptr, nullptr};
                pg8::gemm_phase<pg8::EpiRes<false>, pg8::StaticOrder, true, true>(lds, g, S, E); }
        }
        GRID_BAR();
    }
    { ARGS(); TIDS(); float* const X = A.out; const int gw = blockIdx.x * NWAVES + wave, NGW = G * NWAVES;
      for (int mrow = gw; mrow < T; mrow += NGW) {
        f32x4* xr = (f32x4*)(X + (size_t)mrow * D) + lane; f32x4 v[4]; float s = 0.f;
#pragma unroll
        for (int j = 0; j < 4; ++j) { v[j] = xr[64 * j]; s += (v[j].x * v[j].x + v[j].y * v[j].y) + (v[j].z * v[j].z + v[j].w * v[j].w); }
        const float rstd = 1.f / sqrtf(wave_sum(s) * (1.f / D) + EPS);
#pragma unroll
        for (int j = 0; j < 4; ++j) xr[64 * j] = (v[j] * rstd) * ((const f32x4*)A.final_g)[lane + 64 * j];
      } }
}

extern "C" void kernel_launch(void* const* d_in, const int* in_sizes, int n_in, void* d_out, int out_size, void* d_ws, size_t ws_size, hipStream_t stream) {
    static int grid = 0;
    if (grid == 0) {
        if (n_in != 21 || out_size != T * D || ws_size < WS_END) { fprintf(stderr, "kernel_launch: unexpected shapes (n_in %d out %d ws %zu)\n", n_in, out_size, ws_size); grid = -1; return; }
        int dev = 0, cus = 0, per_cu = 0;
        hipGetDevice(&dev); hipDeviceGetAttribute(&cus, hipDeviceAttributeMultiprocessorCount, dev);
        hipFuncSetAttribute((const void*)hybrid_fwd, hipFuncAttributeMaxDynamicSharedMemorySize, LDS_BYTES);
        if (hipOccupancyMaxActiveBlocksPerMultiprocessor(&per_cu, (const void*)hybrid_fwd, NWAVES * 64, LDS_BYTES) != hipSuccess || per_cu < 1) per_cu = 1;
        (void)hipGetLastError();
        grid = cus * per_cu;
        if (grid != GRID) { fprintf(stderr, "kernel_launch: built for a %d-workgroup resident grid, device offers %d\n", GRID, grid); grid = -1; return; }
    }
    if (grid < 0) return;
    Args a{};
    const float** p = (const float**)&a;
    for (int i = 0; i < 21; ++i) p[i] = (const float*)d_in[i];
    a.out = (float*)d_out; a.ws = (unsigned char*)d_ws;
    void* args[] = {&a};
    hipError_t e = hipLaunchCooperativeKernel((const void*)hybrid_fwd, dim3(grid), dim3(NWAVES * 64), args, LDS_BYTES, stream);
    if (e != hipSuccess) fprintf(stderr, "cooperative launch failed: %s (grid %d)\n", hipGetErrorString(e), grid);
}
```

```cpp
#include <hip/hip_runtime.h>
#include <hip/hip_cooperative_groups.h>
#include <cstdio>
#include <cstdint>
namespace cg = cooperative_groups;
#define TID_TAB_OFF (143360 + 64)
__device__ __forceinline__ int hw_slot() { return (int)(__builtin_amdgcn_s_getreg((5 << 11) | 4) & 63u); }
__device__ __forceinline__ int my_lane() { unsigned z = 0u; asm volatile("" : "+v"(z)); return (int)__builtin_amdgcn_mbcnt_hi(~0u, __builtin_amdgcn_mbcnt_lo(~0u, z)); }
__device__ __forceinline__ int my_tid() {
    extern __shared__ __attribute__((aligned(16))) unsigned char lds_raw[];
    const volatile __attribute__((address_space(3))) int* tab = (const volatile __attribute__((address_space(3))) int*)((__attribute__((address_space(3))) unsigned char*)lds_raw + TID_TAB_OFF);
    const int w = __builtin_amdgcn_readfirstlane(tab[hw_slot()]); return w * 64 + my_lane();
}
namespace pg8 {
#define PG8_LAS __attribute__((address_space(3)))
typedef unsigned short bf16_t;
typedef short bf16x8 __attribute__((ext_vector_type(8)));
typedef float f32x4 __attribute__((ext_vector_type(4)));
typedef unsigned u32x4 __attribute__((ext_vector_type(4)));
constexpr int BM = 256, BK = 64, HALF = 128, HTB = HALF * BK * 2  , STAGE_BYTES = 8 * HTB, NXCD = 8, WGM = 8;

__host__ __device__ __forceinline__ int lds_byte(int r, int c) { const int st = (r >> 4) * 2 + (c >> 5), rr = r & 15, cc = c & 31, ob = rr * 64 + cc * 2; return st * 1024 + (ob ^ (((ob >> 9) & 1) << 5)); }
__host__ __device__ __forceinline__ void stage_rc(int b, int& R, int& C) { const int st = b / 1024, sb = b % 1024, swz = sb ^ (((sb >> 9) & 1) << 5); R = (st >> 1) * 16 + swz / 64; C = (st & 1) * 32 + (swz % 64) / 2; }
__host__ __device__ __forceinline__ int perm32(int rho) { const int n = rho >> 4, i = rho & 15; return 8 * (i >> 2) + 4 * n + (i & 3); }

struct Unit { int pm, pn; };
struct Gemm { const bf16_t* A; const bf16_t* Bt; int M, N, K; };

struct StaticOrder {
    int nM, nN, nwg, G, c;
    __host__ __device__ void init(int M, int N, int G_, int c_) { nM = M / BM; nN = N / BM; nwg = nM * nN; G = G_; c = c_; }
    __host__ __device__ bool next(int i, Unit& u) const {
        const long L = (long)i * G + c; if (L >= nwg) return false;
        int wgid = (int)L; { const int q = nwg / NXCD, r = nwg % NXCD, xcd = wgid % NXCD, off = wgid / NXCD; wgid = (xcd < r ? xcd * (q + 1) : r * (q + 1) + (xcd - r) * q) + off; }
        const int nig = WGM * nN, gid = wgid / nig, fm = gid * WGM, gsz = (nM - fm) < WGM ? (nM - fm) : WGM;
        u.pm = fm + ((wgid % nig) % gsz); u.pn = (wgid % nig) / gsz; return true;
    }
    __device__ __forceinline__ void a_ready(const Unit&) const {}
    __device__ __forceinline__ void done(const Unit&) const {}
};

typedef float f32x2_t __attribute__((ext_vector_type(2))); typedef __bf16 bf16x2_t __attribute__((ext_vector_type(2)));
__device__ __forceinline__ unsigned cvt_pk_bf16(float lo, float hi) { f32x2_t v = {lo, hi}; bf16x2_t b = __builtin_convertvector(v, bf16x2_t); return __builtin_bit_cast(unsigned, b); }

__device__ __forceinline__ int epi_batch(int rbase) { return rbase < 16384 ? (rbase >> 12) : 4 + ((rbase - 16384) >> 14); }
struct EpiBf16R {
    static constexpr bool PERM = true, AFTER_DRAIN = false;
    bf16_t* O; int ldc; int rope_cols; const float* cosT; const float* sinT; const float* ssq; const float* sw; int swld;
    __device__ __forceinline__ void operator()(const f32x4 (&acc)[2][2][4][2], const Unit& u, int wr, int wc, int fr, int fq) const {
        const int row0 = u.pm * BM + wr * 64 + fr; const int col0 = u.pn * BM + wc * 32 + 8 * fq;
        const float* swp = sw + (size_t)epi_batch(u.pm * BM) * swld + col0;
        f32x4 swv[2][2]; float sq[8];
#pragma unroll
        for (int bj = 0; bj < 2; ++bj) { swv[bj][0] = *(const f32x4*)(swp + bj * HALF); swv[bj][1] = *(const f32x4*)(swp + bj * HALF + 4); }
#pragma unroll
        for (int rg = 0; rg < 8; ++rg) sq[rg] = ssq[row0 + (rg >> 2) * HALF + (rg & 3) * 16];
        const bool rope0 = col0 < rope_cols, rope1 = col0 + HALF < rope_cols;
        const int i0 = (col0 & 63) >> 1;
        f32x4 tb[2][2];
#define EPI_TBL(buf, rg) do { const int row_ = row0 + ((rg) >> 2) * HALF + ((rg) & 3) * 16; const size_t po_ = (size_t)(row_ & (row_ < 16384 ? 4095 : 16383)) * 32 + i0; \
            tb[buf][0] = *(const f32x4*)(cosT + po_); tb[buf][1] = *(const f32x4*)(sinT + po_); } while (0)
        if (rope0) EPI_TBL(0, 0);
        asm volatile("" ::: "memory");
#pragma unroll
        for (int rg = 0; rg < 8; ++rg) { const int ai = rg >> 2, m = rg & 3; const int row = row0 + ai * HALF + m * 16; bf16_t* rowp = O + (size_t)row * ldc + col0;
            if (rope0 && rg < 7) { if ((rg & 1) == 0) EPI_TBL(1, rg + 1); else EPI_TBL(0, rg + 1); }
            asm volatile("" ::: "memory");
            const float rstd = __builtin_amdgcn_rsqf(sq[rg] * (1.0f / 1024.0f) + 1e-6f);
#pragma unroll
            for (int bj = 0; bj < 2; ++bj) { f32x4 v0 = acc[ai][bj][m][0] * rstd + swv[bj][0], v1 = acc[ai][bj][m][1] * rstd + swv[bj][1];
                if (bj == 0 ? rope0 : rope1) { const f32x4 cs = tb[rg & 1][0], sn = tb[rg & 1][1];
                    f32x4 w0, w1;
                    w0[0] = v0[0] * cs[0] - v0[1] * sn[0]; w0[1] = v0[0] * sn[0] + v0[1] * cs[0];
                    w0[2] = v0[2] * cs[1] - v0[3] * sn[1]; w0[3] = v0[2] * sn[1] + v0[3] * cs[1];
                    w1[0] = v1[0] * cs[2] - v1[1] * sn[2]; w1[1] = v1[0] * sn[2] + v1[1] * cs[2];
                    w1[2] = v1[2] * cs[3] - v1[3] * sn[3]; w1[3] = v1[2] * sn[3] + v1[3] * cs[3];
                    v0 = w0; v1 = w1; }
                u32x4 w; w.x = cvt_pk_bf16(v0[0], v0[1]); w.y = cvt_pk_bf16(v0[2], v0[3]); w.z = cvt_pk_bf16(v1[0], v1[1]); w.w = cvt_pk_bf16(v1[2], v1[3]);
                *(u32x4*)(rowp + bj * HALF) = w; } }
#undef EPI_TBL
    }
};
typedef float f32x2v __attribute__((ext_vector_type(2)));
__device__ __forceinline__ f32x2v swiglu2(f32x2v g, f32x2v u) { const f32x2v t = g * (-1.4426950408889634f); f32x2v e; e.x = __builtin_amdgcn_exp2f(t.x); e.y = __builtin_amdgcn_exp2f(t.y);
    const f32x2v d = e + 1.0f; f32x2v r; r.x = __builtin_amdgcn_rcpf(d.x); r.y = __builtin_amdgcn_rcpf(d.y); return (g * u) * r; }
struct EpiSwiGLU {
    static constexpr bool PERM = true, AFTER_DRAIN = false;
    bf16_t* O; int ldc; const float* ssq; const float* sw;
    __device__ __forceinline__ void operator()(const f32x4 (&acc)[2][2][4][2], const Unit& u, int wr, int wc, int fr, int fq) const {
        const int row0 = u.pm * BM + wr * 64 + fr; const int col0 = u.pn * HALF + wc * 32 + 8 * fq;
        const float* swp = sw + (size_t)epi_batch(u.pm * BM) * 5632 + u.pn * BM + wc * 32 + 8 * fq;
        const f32x4 sg0 = *(const f32x4*)(swp), sg1 = *(const f32x4*)(swp + 4), su0 = *(const f32x4*)(swp + HALF), su1 = *(const f32x4*)(swp + HALF + 4);
        float sq[8];
#pragma unroll
        for (int rg = 0; rg < 8; ++rg) sq[rg] = ssq[row0 + (rg >> 2) * HALF + (rg & 3) * 16];
        asm volatile("" ::: "memory");
#pragma unroll
        for (int rg = 0; rg < 8; ++rg) { const int ai = rg >> 2, m = rg & 3; const int row = row0 + ai * HALF + m * 16; bf16_t* rowp = O + (size_t)row * ldc + col0;
                const float rstd = __builtin_amdgcn_rsqf(sq[rg] * (1.0f / 1024.0f) + 1e-6f);
                const f32x4 g0 = acc[ai][0][m][0] * rstd + sg0, g1 = acc[ai][0][m][1] * rstd + sg1, u0 = acc[ai][1][m][0] * rstd + su0, u1 = acc[ai][1][m][1] * rstd + su1;
                const f32x2v r0 = swiglu2((f32x2v){g0[0], g0[1]}, (f32x2v){u0[0], u0[1]}), r1 = swiglu2((f32x2v){g0[2], g0[3]}, (f32x2v){u0[2], u0[3]});
                const f32x2v r2 = swiglu2((f32x2v){g1[0], g1[1]}, (f32x2v){u1[0], u1[1]}), r3 = swiglu2((f32x2v){g1[2], g1[3]}, (f32x2v){u1[2], u1[3]});
                u32x4 w; w.x = cvt_pk_bf16(r0.x, r0.y); w.y = cvt_pk_bf16(r1.x, r1.y); w.z = cvt_pk_bf16(r2.x, r2.y); w.w = cvt_pk_bf16(r3.x, r3.y);
                *(u32x4*)rowp = w; }
    }
};
template <bool FUSE> struct EpiRes {
    static constexpr bool PERM = false, AFTER_DRAIN = false;
    const float* srcA; const float* srcB; float* out; const float* gate;
    float* ssqn; const float* gpn; bf16_t* xg;
    __device__ __forceinline__ void operator()(const f32x4 (&acc)[2][2][4][2], const Unit& u, int wr, int wc, int fr, int fq) const {
        const int rbase = u.pm * BM; const int row0 = rbase + wr * 64 + fr, col0 = u.pn * BM + wc * 32 + 4 * fq;
        const int b = epi_batch(rbase);
        const float* src = rbase < 16384 ? srcA : srcB - (size_t)16384 * 1024;
        const float* g = gate + (size_t)b * 6144 + col0; const float* gp = gpn + (size_t)b * 1024 + col0;
        const unsigned ob0 = (unsigned)(row0 * 1024 + col0) * 4u;
        const char* srcb = (const char*)src; char* outb = (char*)out; char* xgb = (char*)xg;
        f32x4 pre[2][8], gv[2], gpv[2]; float s2[4] = {0.f, 0.f, 0.f, 0.f};
#define EPI_RO(ai, m, co) (ob0 + (unsigned)(((ai) * HALF + (m) * 16) * 1024 + (co)) * 4u)
#define EPI_LD(buf, k) do { const int ai_ = (k) >> 1, cb_ = ((k) & 1) * HALF; \
            _Pragma("unroll") for (int n = 0; n < 2; ++n) { gv[n] = *(const f32x4*)(g + cb_ + n * 16); if (FUSE) gpv[n] = *(const f32x4*)(gp + cb_ + n * 16); } \
            _Pragma("unroll") for (int m = 0; m < 4; ++m) _Pragma("unroll") for (int n = 0; n < 2; ++n) pre[buf][m * 2 + n] = *(const f32x4*)(srcb + EPI_RO(ai_, m, cb_ + n * 16)); } while (0)
        EPI_LD(0, 0);
        asm volatile("" ::: "memory");
#pragma unroll
        for (int k = 0; k < 4; ++k) { const int ai = k >> 1, bj = k & 1, cb = bj * HALF;
#pragma unroll
            for (int m = 0; m < 4; ++m)
#pragma unroll
                for (int n = 0; n < 2; ++n) { const f32x4 o = pre[k & 1][m * 2 + n] + gv[n] * acc[ai][bj][m][n]; pre[k & 1][m * 2 + n] = o;
                    if (FUSE) s2[m] += (o[0] * o[0] + o[1] * o[1]) + (o[2] * o[2] + o[3] * o[3]); }
            const f32x4 gpc0 = gpv[0], gpc1 = gpv[1];
            if (k < 3) { if ((k & 1) == 0) EPI_LD(1, k + 1); else EPI_LD(0, k + 1); }
            asm volatile("" ::: "memory");
#pragma unroll
            for (int m = 0; m < 4; ++m)
#pragma unroll
                for (int n = 0; n < 2; ++n) { const unsigned ob = EPI_RO(ai, m, cb + n * 16); const f32x4 o = pre[k & 1][m * 2 + n];
                    *(f32x4*)(outb + ob) = o;
                    if (FUSE) { const f32x4 y = o * (n == 0 ? gpc0 : gpc1); *(unsigned long long*)(xgb + (ob >> 1)) = (unsigned long long)cvt_pk_bf16(y[0], y[1]) | ((unsigned long long)cvt_pk_bf16(y[2], y[3]) << 32); } }
            if (FUSE && bj == 1) {
#pragma unroll
                for (int m = 0; m < 4; ++m) { float t = s2[m]; s2[m] = 0.f; t += __shfl_xor(t, 16); t += __shfl_xor(t, 32); if (fq == 0) __hip_atomic_fetch_add(ssqn + row0 + ai * HALF + m * 16, t, __ATOMIC_RELAXED, __HIP_MEMORY_SCOPE_AGENT); } }
        }
#undef EPI_LD
#undef EPI_RO
    }
};

template <class Epi, class Sched, bool ALIGN_EPI = false, bool SP2 = false>
__device__ __forceinline__ void gemm_phase(PG8_LAS unsigned char* lds, const Gemm g, const Sched& S, const Epi& E) {
    int tid_ = my_tid(); asm volatile("" : "+v"(tid_));
    const int tid = tid_, wid = __builtin_amdgcn_readfirstlane(tid >> 6), lane = tid & 63, wr = wid >> 2, wc = wid & 3, fr = lane & 15, fq = lane >> 4;
    const int K = g.K, nt = K / BK;
    unsigned voffA[2], voffB[2];
#pragma unroll
    for (int i = 0; i < 2; ++i) { int R, C; stage_rc(tid * 16 + i * 8192, R, C); const int Rb = Epi::PERM ? ((R & ~31) + perm32(R & 31)) : R;
        voffA[i] = (unsigned)(R * K + C) * 2u; voffB[i] = (unsigned)(Rb * K + C) * 2u; }
    const size_t kstep = (size_t)(BK * 2);
    const size_t hstep = (size_t)HALF * K * 2;
    const size_t tstep = 2 * hstep;
    const unsigned ldsw = (unsigned)wid * 1024u;
    const int aoff = lds_byte(wr * 64 + fr, fq * 8), boff = lds_byte(wc * 32 + fr, fq * 8);
#define PG8_SA(b, h) (((b) * 2 + (h)) * HTB)
#define PG8_SB(b, h) ((4 + (b) * 2 + (h)) * HTB)
#define PG8_STAGE(bufoff, gbase, voff) do { _Pragma("unroll") for (int _i = 0; _i < 2; ++_i) \
        __builtin_amdgcn_global_load_lds((const unsigned*)((const char*)(gbase) + (voff)[_i]), (PG8_LAS unsigned*)(lds + (bufoff) + ldsw + _i * 8192), 16, 0, 0); } while (0)
#define PG8_LDA(dst, b, h) do { _Pragma("unroll") for (int m = 0; m < 4; ++m) _Pragma("unroll") for (int k = 0; k < 2; ++k) dst[m][k] = *(const PG8_LAS bf16x8*)(lds + PG8_SA(b, h) + aoff + m * 2048 + k * 1024); } while (0)
#define PG8_LDB(dst, b, h) do { _Pragma("unroll") for (int n = 0; n < 2; ++n) _Pragma("unroll") for (int k = 0; k < 2; ++k) dst[n][k] = *(const PG8_LAS bf16x8*)(lds + PG8_SB(b, h) + boff + n * 2048 + k * 1024); } while (0)
#define PG8_MMA(ai, bj, At, Bt) do { __builtin_amdgcn_s_setprio(1); _Pragma("unroll") for (int m = 0; m < 4; ++m) _Pragma("unroll") for (int n = 0; n < 2; ++n) _Pragma("unroll") for (int k = 0; k < 2; ++k) \
        acc[ai][bj][m][n] = __builtin_amdgcn_mfma_f32_16x16x32_bf16(Bt[n][k], At[m][k], acc[ai][bj][m][n], 0, 0, 0); __builtin_amdgcn_s_setprio(0); } while (0)
#define PG8_WAIT_V(n) asm volatile("s_waitcnt vmcnt(" #n ")" ::: "memory")
#define PG8_WAIT_L(n) asm volatile("s_waitcnt lgkmcnt(" #n ")" ::: "memory")
#define PG8_BAR __builtin_amdgcn_s_barrier()
#define PG8_SCHED __builtin_amdgcn_sched_barrier(0)
    Unit cur, nxt; int ui = 0;
    if (!S.next(0, cur)) return;
    f32x4 acc[2][2][4][2];
#pragma unroll
    for (int a = 0; a < 2; ++a)
#pragma unroll
        for (int b = 0; b < 2; ++b)
#pragma unroll
            for (int m = 0; m < 4; ++m)
#pragma unroll
                for (int n = 0; n < 2; ++n) acc[a][b][m][n] = (f32x4){0.f, 0.f, 0.f, 0.f};
    bf16x8 At[4][2], B0[2][2], B1[2][2];
    const char* cA = (const char*)g.A + (size_t)cur.pm * tstep; const char* cB = (const char*)g.Bt + (size_t)cur.pn * tstep;
    S.a_ready(cur);
    if constexpr (SP2) {
        PG8_STAGE(PG8_SB(0, 0), cB, voffB); PG8_STAGE(PG8_SB(0, 1), cB + hstep, voffB); PG8_STAGE(PG8_SA(0, 0), cA, voffA); PG8_STAGE(PG8_SA(0, 1), cA + hstep, voffA);
        if (wr == 1) PG8_BAR;
        PG8_WAIT_V(2); PG8_BAR;
        PG8_STAGE(PG8_SB(1, 0), cB + kstep, voffB); PG8_STAGE(PG8_SA(1, 0), cA + kstep, voffA); PG8_STAGE(PG8_SB(1, 1), cB + hstep + kstep, voffB);
        PG8_WAIT_V(6); PG8_BAR;
    } else {
        PG8_STAGE(PG8_SB(0, 0), cB, voffB); PG8_STAGE(PG8_SA(0, 0), cA, voffA); PG8_STAGE(PG8_SB(0, 1), cB + hstep, voffB); PG8_STAGE(PG8_SA(0, 1), cA + hstep, voffA);
        if (wr == 1) PG8_BAR;
        PG8_WAIT_V(4); PG8_BAR;
        PG8_STAGE(PG8_SB(1, 0), cB + kstep, voffB); PG8_STAGE(PG8_SA(1, 0), cA + kstep, voffA); PG8_STAGE(PG8_SB(1, 1), cB + hstep + kstep, voffB);
        PG8_WAIT_V(6); PG8_BAR;
    }
    for (;;) {
        const bool has_next = S.next(ui + 1, nxt);
        const char* nA = has_next ? (const char*)g.A + (size_t)nxt.pm * tstep : cA; const char* nB = has_next ? (const char*)g.Bt + (size_t)nxt.pn * tstep : cB;
        for (int t = 0; t < nt; t += 2) {
            const bool last = (t == nt - 2);
            const char* a1 = cA + (size_t)(t + 1) * kstep;
            const char* a2 = last ? nA : cA + (size_t)(t + 2) * kstep; const char* b2 = last ? nB : cB + (size_t)(t + 2) * kstep;
            const char* a3 = a2 + kstep; const char* b3 = b2 + kstep;
            if (last && has_next) S.a_ready(nxt);
            if constexpr (SP2) {
            PG8_LDB(B0, 0, 0); PG8_LDB(B1, 0, 1); PG8_SCHED; PG8_LDA(At, 0, 0); PG8_STAGE(PG8_SA(1, 1), a1 + hstep, voffA);
            PG8_WAIT_V(8); PG8_WAIT_L(0); PG8_BAR; PG8_MMA(0, 0, At, B0); PG8_MMA(0, 1, At, B1); PG8_BAR; PG8_SCHED;
            PG8_LDA(At, 0, 1); PG8_STAGE(PG8_SB(0, 0), b2, voffB); PG8_STAGE(PG8_SB(0, 1), b2 + hstep, voffB); PG8_STAGE(PG8_SA(0, 0), a2, voffA);
            PG8_WAIT_V(8); PG8_WAIT_L(0); PG8_BAR; PG8_MMA(1, 0, At, B0); PG8_MMA(1, 1, At, B1); PG8_BAR; PG8_SCHED;
            PG8_LDB(B0, 1, 0); PG8_LDB(B1, 1, 1); PG8_SCHED; PG8_LDA(At, 1, 0); PG8_STAGE(PG8_SA(0, 1), a2 + hstep, voffA);
            PG8_WAIT_V(8); PG8_WAIT_L(0); PG8_BAR; PG8_MMA(0, 0, At, B0); PG8_MMA(0, 1, At, B1); PG8_BAR; PG8_SCHED;
            PG8_LDA(At, 1, 1); PG8_STAGE(PG8_SB(1, 0), b3, voffB); PG8_STAGE(PG8_SB(1, 1), b3 + hstep, voffB); PG8_STAGE(PG8_SA(1, 0), a3, voffA);
            PG8_WAIT_V(8); PG8_WAIT_L(0); PG8_BAR; PG8_MMA(1, 0, At, B0); PG8_MMA(1, 1, At, B1); PG8_BAR; PG8_SCHED;
            } else {
            PG8_LDB(B0, 0, 0); PG8_SCHED; PG8_LDA(At, 0, 0); PG8_STAGE(PG8_SA(1, 1), a1 + hstep, voffA);
            PG8_WAIT_L(8); PG8_BAR; PG8_WAIT_L(0); PG8_MMA(0, 0, At, B0); PG8_BAR; PG8_SCHED;
            PG8_LDB(B1, 0, 1); PG8_STAGE(PG8_SB(0, 0), b2, voffB);
            PG8_BAR; PG8_WAIT_L(0); PG8_MMA(0, 1, At, B1); PG8_BAR;
            PG8_LDA(At, 0, 1); PG8_STAGE(PG8_SA(0, 0), a2, voffA);
            PG8_BAR; PG8_WAIT_L(0); PG8_MMA(1, 0, At, B0); PG8_BAR; PG8_SCHED;
            PG8_STAGE(PG8_SB(0, 1), b2 + hstep, voffB);
            PG8_WAIT_V(6); PG8_BAR; PG8_MMA(1, 1, At, B1); PG8_BAR;
            PG8_LDB(B0, 1, 0); PG8_SCHED; PG8_LDA(At, 1, 0); PG8_STAGE(PG8_SA(0, 1), a2 + hstep, voffA);
            PG8_WAIT_L(8); PG8_BAR; PG8_WAIT_L(0); PG8_MMA(0, 0, At, B0); PG8_BAR; PG8_SCHED;
            PG8_LDB(B1, 1, 1); PG8_STAGE(PG8_SB(1, 0), b3, voffB);
            PG8_BAR; PG8_WAIT_L(0); PG8_MMA(0, 1, At, B1); PG8_BAR;
            PG8_LDA(At, 1, 1); PG8_STAGE(PG8_SA(1, 0), a3, voffA);
            PG8_BAR; PG8_WAIT_L(0); PG8_MMA(1, 0, At, B0); PG8_BAR; PG8_SCHED;
            PG8_STAGE(PG8_SB(1, 1), b3 + hstep, voffB);
            PG8_WAIT_V(6); PG8_BAR; PG8_MMA(1, 1, At, B1); PG8_BAR;
            }
        }
        if constexpr (ALIGN_EPI) { if (wr == 0) PG8_BAR; }
        if constexpr (!Epi::AFTER_DRAIN) { E(acc, cur, wr, wc, fr, fq); S.done(cur); }
        if (!has_next) break;
#pragma unroll
        for (int a = 0; a < 2; ++a)
#pragma unroll
            for (int b = 0; b < 2; ++b)
#pragma unroll
                for (int m = 0; m < 4; ++m)
#pragma unroll
                    for (int n = 0; n < 2; ++n) acc[a][b][m][n] = (f32x4){0.f, 0.f, 0.f, 0.f};
        cur = nxt; cA = nA; cB = nB; ++ui;
        if constexpr (ALIGN_EPI) { if (wr == 1) PG8_BAR; }
    }
    PG8_WAIT_V(0);
    if constexpr (!ALIGN_EPI) { if (wr == 0) PG8_BAR; }
    PG8_BAR;
    if constexpr (Epi::AFTER_DRAIN) { E.fused(acc, cur, wr, wc, fr, fq, lds, wid, lane); S.done(cur); }
#undef PG8_SA
#undef PG8_SB
#undef PG8_STAGE
#undef PG8_LDA
#undef PG8_LDB
#undef PG8_MMA
#undef PG8_WAIT_V
#undef PG8_WAIT_L
#undef PG8_BAR
#undef PG8_SCHED
}
}

constexpr int D = 1024, TP = 16384, TS = 32768, T = TP + TS, LP = 4096, LS = 16384, NB = 6, DFF = 2816;
constexpr int EVEN_IN = 2048, ODD_IN = 2304;
constexpr float EPS = 1e-6f, LOG2E = 1.4426950408889634f;
constexpr int NWAVES = 8, GRID = 256;
constexpr size_t MiB = 1u << 20;
constexpr size_t WS_MOD = 0;
constexpr size_t WS_CTL = 512 * 1024;
constexpr size_t WS_COS = 1 * MiB, WS_SIN = 3 * MiB;
constexpr size_t WS_WINE = 6 * MiB;
constexpr size_t WS_WOE = 10 * MiB;
constexpr size_t WS_WINO = 12 * MiB;
constexpr size_t WS_WOO = 17 * MiB;
constexpr size_t WS_W13 = 19 * MiB;
constexpr size_t WS_W2 = 41 * MiB;
constexpr size_t WS_PW = 52 * MiB;
constexpr size_t WS_HA = 54 * MiB;
constexpr size_t WS_ZR = 150 * MiB;
constexpr size_t WS_H2 = 414 * MiB;
constexpr size_t WS_END = 510 * MiB;
constexpr size_t WS_GP = 640 * 1024;
constexpr size_t WS_SWIN = 5 * MiB;
constexpr size_t WS_SWUP = 5 * MiB + 128 * 1024;
constexpr size_t WS_S = 53 * MiB;
constexpr int LDS_BYTES = 147456;

#define LAS __attribute__((address_space(3)))
typedef unsigned short bf16;
typedef unsigned v4u __attribute__((ext_vector_type(4)));
typedef unsigned v2u __attribute__((ext_vector_type(2)));
typedef float f32x4 __attribute__((ext_vector_type(4)));
typedef float f32x16 __attribute__((ext_vector_type(16)));
typedef short bf16x8 __attribute__((ext_vector_type(8)));
typedef short s16x4 __attribute__((ext_vector_type(4)));
#define LDS_WAIT() asm volatile("s_waitcnt lgkmcnt(0)" ::: "memory")
__device__ __forceinline__ unsigned f2bf(float f) { unsigned u = __builtin_bit_cast(unsigned, f); return (u + 0x7fffu + ((u >> 16) & 1u)) >> 16; }
__device__ __forceinline__ unsigned pk2(float lo, float hi) { return f2bf(lo) | (f2bf(hi) << 16); }
__device__ __forceinline__ float bflo(unsigned w) { return __builtin_bit_cast(float, w << 16); }
__device__ __forceinline__ float bfhi(unsigned w) { return __builtin_bit_cast(float, w & 0xffff0000u); }
__device__ __forceinline__ float wave_sum(float v) {
#pragma unroll
    for (int o = 1; o < 64; o <<= 1) v += __shfl_xor(v, o);
    return v;
}
__device__ __forceinline__ int crow(int r, int hi) { return (r & 3) + 8 * (r >> 2) + 4 * hi; }

struct Args {
    const float *x_p, *x_s, *c_p, *c_s, *ada_w, *ada_b, *norm_g, *final_g, *w1, *w3, *w2, *even_w_in, *rpb, *pool_w, *pool_scale, *even_w_out,
                *odd_w_in, *sink, *conv_w, *conv_b, *odd_w_out;
    float* out; unsigned char* ws;
};
typedef const __attribute__((address_space(4))) Args* CArgsPtr;
__device__ __forceinline__ CArgsPtr args_ptr() { CArgsPtr p = (CArgsPtr)__builtin_amdgcn_kernarg_segment_ptr(); asm volatile("" : "+s"(p)); return p; }

template <class RowMap>
__device__ __forceinline__ void p0_transpose_item(const float* W, int K, int N, bf16* WT, LAS float* scr, int item, int lane, RowMap rowmap) {
    const int nblk = N / 32, kb = item / nblk, nb = item % nblk, k0 = 64 * kb, n0 = 32 * nb;
#pragma unroll 8
    for (int i = 0; i < 32; ++i) { const int kk = 2 * i + (lane >> 5); scr[kk * 33 + (lane & 31)] = W[(size_t)(k0 + kk) * N + n0 + (lane & 31)]; }
    LDS_WAIT(); asm volatile("" ::: "memory");
    const int c = lane & 7;
#pragma unroll
    for (int j = 0; j < 4; ++j) { const int n = (lane >> 3) + 8 * j; const LAS float* s = scr + (8 * c) * 33 + n;
        v4u o; o.x = pk2(s[0 * 33], s[1 * 33]); o.y = pk2(s[2 * 33], s[3 * 33]); o.z = pk2(s[4 * 33], s[5 * 33]); o.w = pk2(s[6 * 33], s[7 * 33]);
        *(v4u*)(WT + (size_t)rowmap(n0 + n) * K + k0 + 8 * c) = o; }
    LDS_WAIT(); asm volatile("" ::: "memory");
}
struct MapId { __device__ __forceinline__ int operator()(int n) const { return n; } };
struct MapRope { __device__ __forceinline__ int operator()(int n) const { if (n >= 640) return n; const int d = n & 63; return (n & ~63) + ((d & 31) << 1) + (d >> 5); } };
struct MapW1 { __device__ __forceinline__ int operator()(int n) const { return ((n >> 7) << 8) + (n & 127); } };
struct MapW3 { __device__ __forceinline__ int operator()(int n) const { return ((n >> 7) << 8) + 128 + (n & 127); } };

__device__ __forceinline__ int batch_of(int row) { return row < TP ? (row >> 12) : 4 + ((row - TP) >> 14); }

__device__ __forceinline__ void norm_row(const float* xrow, const float* gam, const float* sc, bf16* orow, float* sq, int lane) {
    const f32x4* xr = (const f32x4*)xrow + lane;
    f32x4 v[4]; float s = 0.f;
#pragma unroll
    for (int j = 0; j < 4; ++j) { v[j] = xr[64 * j]; s += (v[j].x * v[j].x + v[j].y * v[j].y) + (v[j].z * v[j].z + v[j].w * v[j].w); }
    s = wave_sum(s); if (lane == 0) *sq = s;
    unsigned long long* o8 = (unsigned long long*)orow + lane;
#pragma unroll
    for (int j = 0; j < 4; ++j) { const f32x4 g = ((const f32x4*)gam)[lane + 64 * j], a = ((const f32x4*)sc)[lane + 64 * j];
        const f32x4 y = v[j] * g * (a + 1.0f);
        o8[64 * j] = (unsigned long long)pk2(y.x, y.y) | ((unsigned long long)pk2(y.z, y.w) << 32); }
}
__device__ __forceinline__ void p1_phase(const Args& A, LAS unsigned char* lds, int tid, int lane, int wave, int G) {
    const float* mod = (const float*)(A.ws + WS_MOD);
    float* GP = (float*)(A.ws + WS_GP);
    for (int i = blockIdx.x * NWAVES * 64 + tid; i < 4 * NB * D; i += G * NWAVES * 64) { const int sidx = i / (NB * D), b = (i / D) % NB, k = i & 1023; const int l = sidx >> 1, wh = sidx & 1;
        GP[i] = A.norm_g[sidx * D + k] * (1.0f + mod[((size_t)l * NB + b) * 6144 + wh * 3072 + 1024 + k]); }
    LAS float* shv = (LAS float*)lds;
    LAS float* part = (LAS float*)(lds + 24576);
    float* SWin = (float*)(A.ws + WS_SWIN); float* SWup = (float*)(A.ws + WS_SWUP);
    for (int cb = blockIdx.x; cb < 244; cb += G) {
        const float* W; int N, n0, l, wh, kind; int r = cb;
        if (r < 32) { kind = 0; l = 0; wh = 0; W = A.even_w_in; N = EVEN_IN; n0 = r * 64; }
        else if (r < 68) { r -= 32; kind = 1; l = 1; wh = 0; W = A.odd_w_in; N = ODD_IN; n0 = r * 64; }
        else { r -= 68; const int q = r / 44; l = q >> 1; kind = 2 + (q & 1); wh = 1; W = (kind == 2 ? A.w1 : A.w3) + (size_t)l * D * DFF; N = DFF; n0 = (r % 44) * 64; }
        __syncthreads();
        for (int i = tid; i < NB * D; i += NWAVES * 64) { const int b = i >> 10, k = i & 1023; shv[i] = mod[((size_t)l * NB + b) * 6144 + wh * 3072 + k]; }
        __syncthreads();
        const int n = n0 + lane; const float* w = W + n; float acc[NB] = {0.f, 0.f, 0.f, 0.f, 0.f, 0.f}; const int k0 = wave * 128;
#pragma unroll 16
        for (int k = 0; k < 128; ++k) { const float wv = w[(size_t)(k0 + k) * N];
#pragma unroll
            for (int b = 0; b < NB; ++b) acc[b] += shv[b * D + k0 + k] * wv; }
#pragma unroll
        for (int b = 0; b < NB; ++b) part[(wave * NB + b) * 64 + lane] = acc[b];
        __syncthreads();
        if (wave < NB) { float sm = 0.f;
#pragma unroll
            for (int w8 = 0; w8 < NWAVES; ++w8) sm += part[(w8 * NB + wave) * 64 + lane];
            const int nn = kind == 1 ? MapRope()(n) : (kind == 2 ? MapW1()(n) : (kind == 3 ? MapW3()(n) : n));
            float* dst = kind < 2 ? SWin + ((size_t)l * NB + wave) * ODD_IN : SWup + ((size_t)l * NB + wave) * 5632; dst[nn] = sm; }
    }
    __syncthreads();
    const int gw = blockIdx.x * NWAVES + wave, NGW = G * NWAVES;
    bf16* H = (bf16*)(A.ws + WS_HA); float* S0 = (float*)(A.ws + WS_S);
    for (int m = gw; m < T; m += NGW) {
        const int b = batch_of(m); const float* xrow = m < TP ? A.x_p + (size_t)m * D : A.x_s + (size_t)(m - TP) * D;
        norm_row(xrow, A.norm_g, mod + (size_t)b * 6144 + 1024, H + (size_t)m * D, S0 + m, lane);
    }
}

#define MFMA32(a, b, c) __builtin_amdgcn_mfma_f32_32x32x16_bf16((a), (b), (c), 0, 0, 0)
struct KVFrag { v4u kld[4]; };
constexpr int KROW = 144, FL_K = 0, FL_V = 4608, FL_BYTES = 8704;
__device__ __forceinline__ void flash_load(KVFrag& f, const bf16* Kp, int ldz, int lane) {
#pragma unroll
    for (int i = 0; i < 4; ++i) f.kld[i] = *(const v4u*)(Kp + (size_t)((lane >> 3) + 8 * i) * ldz + (lane & 7) * 8);
    asm volatile("" ::: "memory");
}
template <class RP>
__device__ __forceinline__ void frag_rows_via_lds(bf16x8 (&fr)[4], LAS unsigned char* img, int lane, const RP& rowptr) {
    v4u t[4];
#pragma unroll
    for (int i = 0; i < 4; ++i) t[i] = *(const v4u*)(rowptr((lane >> 3) + 8 * i) + (lane & 7) * 8);
#pragma unroll
    for (int i = 0; i < 4; ++i) *(LAS v4u*)(img + ((lane >> 3) + 8 * i) * KROW + (lane & 7) * 16) = t[i];
    LDS_WAIT();
#pragma unroll
    for (int ds = 0; ds < 4; ++ds) fr[ds] = *(const LAS bf16x8*)(img + (lane & 31) * KROW + 32 * ds + 16 * (lane >> 5));
    LDS_WAIT();
}
struct FState { float m, l; f32x16 o[2]; };
template <class SF>
__device__ __forceinline__ bf16x8 flash_softmax(f32x16& p, FState& st, const SF& sf, bf16x8& pb1) {
    float mx = -INFINITY;
#pragma unroll
    for (int r = 0; r < 16; ++r) { p[r] = sf(p[r], r); mx = fmaxf(mx, p[r]); }
    mx = fmaxf(mx, __shfl_xor(mx, 32));
    const float mnew = fmaxf(st.m, mx);
    if (__builtin_amdgcn_ballot_w64(mnew > st.m) != 0ull) {
        const float alpha = __builtin_amdgcn_exp2f(st.m - mnew); st.l *= alpha;
#pragma unroll
        for (int r = 0; r < 16; ++r) { st.o[0][r] *= alpha; st.o[1][r] *= alpha; }
        st.m = mnew;
    }
    float rs = 0.f;
#pragma unroll
    for (int r = 0; r < 16; ++r) { p[r] = __builtin_amdgcn_exp2f(p[r] - st.m); rs += p[r]; }
    st.l += rs;
    v4u w0, w1;
    w0.x = pg8::cvt_pk_bf16(p[0], p[1]); w0.y = pg8::cvt_pk_bf16(p[2], p[3]); w0.z = pg8::cvt_pk_bf16(p[4], p[5]); w0.w = pg8::cvt_pk_bf16(p[6], p[7]);
    w1.x = pg8::cvt_pk_bf16(p[8], p[9]); w1.y = pg8::cvt_pk_bf16(p[10], p[11]); w1.z = pg8::cvt_pk_bf16(p[12], p[13]); w1.w = pg8::cvt_pk_bf16(p[14], p[15]);
    pb1 = __builtin_bit_cast(bf16x8, w1); return __builtin_bit_cast(bf16x8, w0);
}
template <class SFA, class SFB>
__device__ __forceinline__ void flash_compute2(KVFrag& f, const bf16* cV, bool has_next, const bf16* nK, int ldz, LAS unsigned char* vt, const bf16x8 (&qa)[4], const bf16x8 (&qb)[4],
                                               FState& sa, FState& sb, int lane, const SFA& sfa, const SFB& sfb) {
    const int hi = lane >> 5;
    v4u vld[4];
#pragma unroll
    for (int i = 0; i < 4; ++i) { *(LAS v4u*)(vt + FL_K + ((lane >> 3) + 8 * i) * KROW + (lane & 7) * 16) = f.kld[i]; vld[i] = *(const v4u*)(cV + (size_t)((lane >> 3) + 8 * i) * ldz + (lane & 7) * 8); }
    asm volatile("" ::: "memory");
    LDS_WAIT();
    f32x16 pa = {}, pbv = {};
    { bf16x8 kf[4];
#pragma unroll
      for (int ds = 0; ds < 4; ++ds) kf[ds] = *(const LAS bf16x8*)(vt + FL_K + (lane & 31) * KROW + 32 * ds + 16 * hi);
#pragma unroll
      for (int ds = 0; ds < 4; ++ds) { pa = MFMA32(kf[ds], qa[ds], pa); pbv = MFMA32(kf[ds], qb[ds], pbv); } }
    if (has_next) flash_load(f, nK, ldz, lane);
    bf16x8 a0, a1, b0, b1;
    a0 = flash_softmax(pa, sa, sfa, a1);
    b0 = flash_softmax(pbv, sb, sfb, b1);
#pragma unroll
    for (int i = 0; i < 4; ++i) *(LAS v4u*)(vt + FL_V + ((lane >> 3) + 8 * i) * 128 + (lane & 7) * 16) = vld[i];
    LDS_WAIT();
    const int i16 = lane & 15, q4 = i16 >> 2, p4 = i16 & 3, blk = (lane >> 4) & 1;
#pragma unroll
    for (int dh = 0; dh < 2; ++dh)
#pragma unroll
        for (int s = 0; s < 2; ++s) {
            const LAS unsigned char* a_ = vt + FL_V + (16 * s + 4 * hi + q4) * 128 + (32 * dh + 16 * blk) * 2 + 8 * p4;
            const s16x4 lo = __builtin_bit_cast(s16x4, __builtin_amdgcn_ds_read_tr16_b64_v4i16((LAS s16x4*)a_));
            const s16x4 hh = __builtin_bit_cast(s16x4, __builtin_amdgcn_ds_read_tr16_b64_v4i16((LAS s16x4*)(a_ + 8 * 128)));
            const bf16x8 vf = __builtin_shufflevector(lo, hh, 0, 1, 2, 3, 4, 5, 6, 7);
            sa.o[dh] = MFMA32(vf, s == 0 ? a0 : a1, sa.o[dh]);
            sb.o[dh] = MFMA32(vf, s == 0 ? b0 : b1, sb.o[dh]);
        }
    LDS_WAIT();
}
template <class RP>
__device__ __forceinline__ void flash_store(LAS unsigned char* img, const RP& orow, const f32x16 (&o)[2], float l, int lane) {
    const int hi = lane >> 5, r32 = lane & 31; const float inv = 1.0f / (l + __shfl_xor(l, 32));
#pragma unroll
    for (int dh = 0; dh < 2; ++dh)
#pragma unroll
        for (int g = 0; g < 4; ++g) { v2u w; w.x = pg8::cvt_pk_bf16(o[dh][4 * g] * inv, o[dh][4 * g + 1] * inv); w.y = pg8::cvt_pk_bf16(o[dh][4 * g + 2] * inv, o[dh][4 * g + 3] * inv);
            *(LAS v2u*)(img + r32 * KROW + (32 * dh + 8 * g + 4 * hi) * 2) = w; }
    LDS_WAIT();
    v4u t[4];
#pragma unroll
    for (int i = 0; i < 4; ++i) t[i] = *(const LAS v4u*)(img + ((lane >> 3) + 8 * i) * KROW + (lane & 7) * 16);
#pragma unroll
    for (int i = 0; i < 4; ++i) *(v4u*)(orow((lane >> 3) + 8 * i) + (lane & 7) * 8) = t[i];
    LDS_WAIT();
}

__device__ __forceinline__ void p0_phase(const Args& A, LAS unsigned char* lds, int tid, int lane, int wave, int G) {
    float* mod = (float*)(A.ws + WS_MOD);
    {
        LAS float* cact = (LAS float*)lds;
        LAS float* part = (LAS float*)(lds + 24576);
        for (int i = tid; i < NB * D; i += NWAVES * 64) { const int b = i >> 10, k = i & 1023; const float c = b < 4 ? A.c_p[b * D + k] : A.c_s[(b - 4) * D + k]; cact[i] = c / (1.0f + __expf(-c)); }
        __syncthreads();
        for (int cb = blockIdx.x; cb < 2 * 6144 / 64; cb += G) {
            const int layer = cb / 96, j = (cb % 96) * 64 + lane; const float* w = A.ada_w + (size_t)layer * D * 6144 + j;
            float acc[NB] = {0.f, 0.f, 0.f, 0.f, 0.f, 0.f};
            const int k0 = wave * 128;
#pragma unroll 16
            for (int k = 0; k < 128; ++k) { const float wv = w[(size_t)(k0 + k) * 6144];
#pragma unroll
                for (int b = 0; b < NB; ++b) acc[b] += cact[b * D + k0 + k] * wv; }
#pragma unroll
            for (int b = 0; b < NB; ++b) part[(wave * NB + b) * 64 + lane] = acc[b];
            __syncthreads();
            if (wave < NB) { float s = A.ada_b[layer * 6144 + j];
#pragma unroll
                for (int w8 = 0; w8 < NWAVES; ++w8) s += part[(w8 * NB + wave) * 64 + lane];
                mod[((size_t)layer * NB + wave) * 6144 + j] = s; }
            __syncthreads();
        }
    }
    const int gw = blockIdx.x * NWAVES + wave, NGW = G * NWAVES;
    { float* S = (float*)(A.ws + WS_S) + T; for (int i = blockIdx.x * NWAVES * 64 + tid; i < 3 * T; i += G * NWAVES * 64) S[i] = 0.f; }
    {
        float* cosT = (float*)(A.ws + WS_COS); float* sinT = (float*)(A.ws + WS_SIN);
        for (int i = blockIdx.x * NWAVES * 64 + tid; i < 16384 * 32; i += G * NWAVES * 64) {
            const int pos = i >> 5, k = i & 31; const float inv = 1.0f / powf(10000.0f, (float)(2 * k) / 64.0f); const float ang = (float)pos * inv;
            double s, c; sincos((double)ang, &s, &c); cosT[i] = (float)c; sinT[i] = (float)s; }
    }
    {
        LAS float* scr = (LAS float*)(lds + 65536 + wave * 8704);
        constexpr int I_WINE = 16 * 64, I_WO = 16 * 32, I_WINO = 16 * 72, I_W1 = 16 * 88, I_W2 = 44 * 32, I_PW = 2 * 4;
        constexpr int NITEMS = I_WINE + 2 * I_WO + I_WINO + 4 * I_W1 + 2 * I_W2 + 4 * I_PW;
        bf16* ws16 = (bf16*)A.ws;
        for (int it = gw; it < NITEMS; it += NGW) {
            int r = it;
            if (r < I_WINE) { p0_transpose_item(A.even_w_in, D, EVEN_IN, (bf16*)(A.ws + WS_WINE), scr, r, lane, MapId()); continue; } r -= I_WINE;
            if (r < I_WO) { p0_transpose_item(A.even_w_out, D, D, (bf16*)(A.ws + WS_WOE), scr, r, lane, MapId()); continue; } r -= I_WO;
            if (r < I_WO) { p0_transpose_item(A.odd_w_out, D, D, (bf16*)(A.ws + WS_WOO), scr, r, lane, MapId()); continue; } r -= I_WO;
            if (r < I_WINO) { p0_transpose_item(A.odd_w_in, D, ODD_IN, (bf16*)(A.ws + WS_WINO), scr, r, lane, MapRope()); continue; } r -= I_WINO;
            if (r < 2 * I_W1) { const int l = r / I_W1; p0_transpose_item(A.w1 + (size_t)l * D * DFF, D, DFF, (bf16*)(A.ws + WS_W13) + (size_t)l * 5632 * D, scr, r % I_W1, lane, MapW1()); continue; } r -= 2 * I_W1;
            if (r < 2 * I_W1) { const int l = r / I_W1; p0_transpose_item(A.w3 + (size_t)l * D * DFF, D, DFF, (bf16*)(A.ws + WS_W13) + (size_t)l * 5632 * D, scr, r % I_W1, lane, MapW3()); continue; } r -= 2 * I_W1;
            if (r < 2 * I_W2) { const int l = r / I_W2; p0_transpose_item(A.w2 + (size_t)l * DFF * D, DFF, D, (bf16*)(A.ws + WS_W2) + (size_t)l * D * DFF, scr, r % I_W2, lane, MapId()); continue; } r -= 2 * I_W2;
            {
              const int g = r / I_PW, rem = r % I_PW, et = rem >> 1, kh = rem & 1; const float* pw = A.pool_w + (size_t)g * 128 * 128; bf16* dst = (bf16*)(A.ws + WS_PW);
#pragma unroll
              for (int kk = 0; kk < 4; ++kk) { const int ks = kh * 4 + kk; const int e = 32 * et + (lane & 31), c0_ = 16 * ks + 8 * (lane >> 5);
                  v4u o; o.x = pk2(pw[(size_t)(c0_ + 0) * 128 + e], pw[(size_t)(c0_ + 1) * 128 + e]); o.y = pk2(pw[(size_t)(c0_ + 2) * 128 + e], pw[(size_t)(c0_ + 3) * 128 + e]);
                  o.z = pk2(pw[(size_t)(c0_ + 4) * 128 + e], pw[(size_t)(c0_ + 5) * 128 + e]); o.w = pk2(pw[(size_t)(c0_ + 6) * 128 + e], pw[(size_t)(c0_ + 7) * 128 + e]);
                  *(v4u*)(dst + ((size_t)((g * 4 + et) * 8 + ks) * 64 + lane) * 8) = o; } }
        }
        (void)ws16;
    }
}

struct SfNA { const LAS float* rp; int wb, hi;
    __device__ __forceinline__ float operator()(float p, int r) const { const int cr = crow(r, hi); const bool ok = (unsigned)(wb + cr) < 16u; return ok ? p * (0.125f * LOG2E) + rp[cr] : -INFINITY; } };
__device__ __forceinline__ void even_mixer_phase(const Args& A, LAS unsigned char* lds, int tid, int lane, int wave, int G) {
    const bf16* Z = (const bf16*)(A.ws + WS_ZR); bf16* AO = (bf16*)(A.ws + WS_HA);
    LAS float* rpb = (LAS float*)lds;
    for (int i = tid; i < 8 * 15 * 64; i += NWAVES * 64) { const int dc = (i & 63) - 16; rpb[i] = (dc >= 0 && dc < 31) ? A.rpb[(i >> 6) * 31 + dc] * LOG2E : 0.f; }
    __syncthreads();
    LAS unsigned char* vt = lds + 32768 + wave * 13056;
    const int gw = blockIdx.x * NWAVES + wave, NGW = G * NWAVES; const int r32 = lane & 31, hi = lane >> 5;
    constexpr int NTT = T / 32;
    constexpr int NQT = T / 64;
#pragma unroll 1
    for (int it = gw; it < NQT * 8; it += NGW) {
        const int hh = it / NQT, tt = it % NQT;
        int sb, rows, rem; if (tt < 256) { sb = (tt >> 6) * LP; rows = 64; rem = tt & 63; } else { const int t2 = tt - 256; sb = TP + (t2 >> 8) * LS; rows = 256; rem = t2 & 255; }
        const int r0 = (rem >> 2) * 4, c0 = (rem & 3) * 16;
        const int rqa = r0 + (r32 >> 4), rqb = rqa + 2, cq = c0 + (r32 & 15); int cs = cq - 8; cs = cs < 0 ? 0 : (cs > 48 ? 48 : cs);
        int rsa = rqa - 4; rsa = rsa < 0 ? 0 : (rsa > rows - 8 ? rows - 8 : rsa); int rsb = rqb - 4; rsb = rsb < 0 ? 0 : (rsb > rows - 8 ? rows - 8 : rsb);
        int rs0 = r0 - 4; rs0 = rs0 < 0 ? 0 : (rs0 > rows - 8 ? rows - 8 : rs0); int rs3 = r0 - 1; rs3 = rs3 < 0 ? 0 : (rs3 > rows - 8 ? rows - 8 : rs3);
        const int nkr = rs3 + 8 - rs0;
        int kc0 = c0 - 8; kc0 = kc0 < 0 ? 0 : (kc0 > 32 ? 32 : kc0);
        const size_t qta = (size_t)sb + rqa * 64 + cq, qtb = qta + 128;
        bf16x8 qa[4], qb[4];
        const size_t tokbase = (size_t)sb + r0 * 64 + c0;
        frag_rows_via_lds(qa, vt + FL_K, lane, [&](int rr) { return Z + (tokbase + (rr >> 4) * 64 + (rr & 15)) * EVEN_IN + hh * 64; });
        frag_rows_via_lds(qb, vt + FL_K, lane, [&](int rr) { return Z + (tokbase + 128 + (rr >> 4) * 64 + (rr & 15)) * EVEN_IN + hh * 64; });
        FState sa, sbs; sa.m = -1e30f; sa.l = 0.f; sa.o[0] = f32x16{}; sa.o[1] = f32x16{}; sbs.m = -1e30f; sbs.l = 0.f; sbs.o[0] = f32x16{}; sbs.o[1] = f32x16{};
        const bf16* kbase = Z + ((size_t)sb + rs0 * 64 + kc0) * EVEN_IN + 512 + hh * 64;
        KVFrag f;
        flash_load(f, kbase, EVEN_IN, lane);
#pragma unroll 1
        for (int i = 0; i < nkr; ++i) {
            const int kr = rs0 + i; const bf16* nk = kbase + (size_t)(i + 1) * 64 * EVEN_IN;
            int dra = kr - rqa + 7; dra = dra < 0 ? 0 : (dra > 14 ? 14 : dra); int drb = kr - rqb + 7; drb = drb < 0 ? 0 : (drb > 14 ? 14 : drb);
            const int dcb = kc0 - cq + 15, wbase = dcb - (cs - cq + 15);
            SfNA sfa{rpb + (hh * 15 + dra) * 64 + 16 + dcb, (kr >= rsa && kr < rsa + 8) ? wbase : 0x40000000, hi}, sfb{rpb + (hh * 15 + drb) * 64 + 16 + dcb, (kr >= rsb && kr < rsb + 8) ? wbase : 0x40000000, hi};
            flash_compute2(f, nk - (size_t)64 * EVEN_IN + 512, i + 1 < nkr, nk, EVEN_IN, vt, qa, qb, sa, sbs, lane, sfa, sfb);
        }
        flash_store(vt + FL_K, [&](int rr) { return AO + (tokbase + (rr >> 4) * 64 + (rr & 15)) * D + hh * 64; }, sa.o, sa.l, lane);
        flash_store(vt + FL_K, [&](int rr) { return AO + (tokbase + 128 + (rr >> 4) * 64 + (rr & 15)) * D + hh * 64; }, sbs.o, sbs.l, lane);
    }
    { int lane_p = lane; asm volatile("" : "+v"(lane_p));
    const int lane = lane_p, r32 = lane & 31, hi = lane >> 5;
    const float* const pool_scale = args_ptr()->pool_scale;
    const bf16* PW = (const bf16*)(A.ws + WS_PW);
#pragma unroll 1
    for (int it = gw; it < NTT * 4; it += NGW) {
        const int g = it / NTT, tt = it % NTT, t0 = tt * 32, w = 2 << g, half = w >> 1;
        const int L = t0 < TP ? LP : LS, pos0 = t0 & (L - 1), sb = t0 - pos0, pos = pos0 + r32;
        const int lo = pos - half < 0 ? 0 : pos - half, hiw = pos + half > L ? L : pos + half; const float rc = 1.0f / (float)(hiw - lo);
#pragma unroll
        for (int i = 0; i < 12; ++i) { const int row = (lane >> 4) + 4 * i; int tp = pos0 - 8 + row; tp = tp < 0 ? 0 : (tp >= L ? L - 1 : tp);
            const v4u v = *(const v4u*)(Z + (size_t)(sb + tp) * EVEN_IN + 1536 + g * 128 + (lane & 15) * 8);
            *(LAS v4u*)(vt + row * 272 + (lane & 15) * 16) = v; }
        LDS_WAIT();
        const LAS unsigned char* lrow = vt + (r32 + 8 - half) * 272 + hi * 16;
        float sm[8][8];
#pragma unroll
        for (int ks = 0; ks < 8; ++ks)
#pragma unroll
            for (int e = 0; e < 8; ++e) sm[ks][e] = 0.f;
#pragma unroll 2
        for (int j = 0; j < w; ++j) { const int tp = pos - half + j; const float wt = (tp >= 0 && tp < L) ? 1.0f : 0.0f;
            v4u v[8];
#pragma unroll
            for (int ks = 0; ks < 8; ++ks) v[ks] = *(const LAS v4u*)(lrow + j * 272 + 32 * ks);
#pragma unroll
            for (int ks = 0; ks < 8; ++ks) { sm[ks][0] += wt * bflo(v[ks].x); sm[ks][1] += wt * bfhi(v[ks].x); sm[ks][2] += wt * bflo(v[ks].y); sm[ks][3] += wt * bfhi(v[ks].y);
                sm[ks][4] += wt * bflo(v[ks].z); sm[ks][5] += wt * bfhi(v[ks].z); sm[ks][6] += wt * bflo(v[ks].w); sm[ks][7] += wt * bfhi(v[ks].w); } }
        bf16x8 bfr[8];
        { const LAS unsigned char* crow_ = vt + (r32 + 8) * 272 + hi * 16;
#pragma unroll
          for (int ks = 0; ks < 8; ++ks) { const v4u u = *(const LAS v4u*)(crow_ + 32 * ks);
            v4u mx; mx.x = pg8::cvt_pk_bf16(sm[ks][0] * rc - bflo(u.x), sm[ks][1] * rc - bfhi(u.x)); mx.y = pg8::cvt_pk_bf16(sm[ks][2] * rc - bflo(u.y), sm[ks][3] * rc - bfhi(u.y));
            mx.z = pg8::cvt_pk_bf16(sm[ks][4] * rc - bflo(u.z), sm[ks][5] * rc - bfhi(u.z)); mx.w = pg8::cvt_pk_bf16(sm[ks][6] * rc - bflo(u.w), sm[ks][7] * rc - bfhi(u.w));
            bfr[ks] = __builtin_bit_cast(bf16x8, mx); } }
        LDS_WAIT();
#pragma unroll
        for (int et = 0; et < 4; ++et) { f32x16 acc = {};
#pragma unroll
            for (int ks = 0; ks < 8; ++ks) { const bf16x8 af = *(const bf16x8*)(PW + ((size_t)((g * 4 + et) * 8 + ks) * 64 + lane) * 8); acc = MFMA32(af, bfr[ks], acc); }
            const float* scl = pool_scale + g * 128 + 32 * et;
#pragma unroll
            for (int q = 0; q < 4; ++q) { const f32x4 sv = *(const f32x4*)(scl + 8 * q + 4 * hi); v2u wv; wv.x = pg8::cvt_pk_bf16(acc[4 * q] * sv.x, acc[4 * q + 1] * sv.y); wv.y = pg8::cvt_pk_bf16(acc[4 * q + 2] * sv.z, acc[4 * q + 3] * sv.w);
                *(LAS v2u*)(vt + r32 * 272 + (32 * et + 8 * q + 4 * hi) * 2) = wv; } }
        LDS_WAIT();
        { v4u t[8];
#pragma unroll
          for (int i = 0; i < 8; ++i) t[i] = *(const LAS v4u*)(vt + ((lane >> 4) + 4 * i) * 272 + (lane & 15) * 16);
#pragma unroll
          for (int i = 0; i < 8; ++i) *(v4u*)(AO + (size_t)(t0 + (lane >> 4) + 4 * i) * D + 512 + g * 128 + (lane & 15) * 8) = t[i]; }
        LDS_WAIT();
    }
}
}

struct SfSWA { int mode, qi, hi;
    __device__ __forceinline__ float operator()(float p, int r) const { const int ki = crow(r, hi); const bool ok = mode == 0 || (mode < 0 ? ki >= qi : ki <= qi); return ok ? p * (0.125f * LOG2E) : -INFINITY; } };
__device__ __forceinline__ void odd_mixer_phase(const Args& A, LAS unsigned char* lds, int tid, int lane, int wave, int G) {
    const bf16* Z = (const bf16*)(A.ws + WS_ZR); bf16* AO = (bf16*)(A.ws + WS_HA);
    LAS unsigned char* vt = lds + 16384 + wave * FL_BYTES;
    const int gw = blockIdx.x * NWAVES + wave, NGW = G * NWAVES; const int r32 = lane & 31, hi = lane >> 5;
    constexpr int NTT = T / 32;
#pragma unroll 1
    for (int it = gw; it < NTT * 4; it += NGW) {
        const int hp = it / NTT, tt = it % NTT, t0 = tt * 32, hq = hp * 2, kvh = hp >> 1;
        const int L = t0 < TP ? LP : LS, pos0 = t0 & (L - 1), sb = t0 - pos0;
        bf16x8 qa[4], qb[4];
        frag_rows_via_lds(qa, vt + FL_K, lane, [&](int rr) { return Z + (size_t)(t0 + rr) * ODD_IN + hq * 64; });
        frag_rows_via_lds(qb, vt + FL_K, lane, [&](int rr) { return Z + (size_t)(t0 + rr) * ODD_IN + hq * 64 + 64; });
        FState sa, sbs; sa.m = A.sink[hq] * LOG2E; sa.l = hi == 0 ? 1.0f : 0.0f; sa.o[0] = f32x16{}; sa.o[1] = f32x16{};
        sbs.m = A.sink[hq + 1] * LOG2E; sbs.l = hi == 0 ? 1.0f : 0.0f; sbs.o[0] = f32x16{}; sbs.o[1] = f32x16{};
        int jlo = -(pos0 >> 5); jlo = jlo < -4 ? -4 : jlo; int jhi = (L - 32 - pos0) >> 5; jhi = jhi > 4 ? 4 : jhi;
        const bf16* kbase = Z + ((size_t)sb + pos0) * ODD_IN + 512 + kvh * 64;
        KVFrag f;
        flash_load(f, kbase + (ptrdiff_t)jlo * 32 * ODD_IN, ODD_IN, lane);
#pragma unroll 1
        for (int jt = jlo; jt <= jhi; ++jt) {
            const bf16* nk = kbase + (ptrdiff_t)(jt + 1) * 32 * ODD_IN;
            SfSWA sf{jt == -4 ? -1 : (jt == 4 ? 1 : 0), r32, hi};
            flash_compute2(f, nk - (ptrdiff_t)32 * ODD_IN + 128, jt < jhi, nk, ODD_IN, vt, qa, qb, sa, sbs, lane, sf, sf);
        }
        flash_store(vt + FL_K, [&](int rr) { return AO + (size_t)(t0 + rr) * D + hq * 64; }, sa.o, sa.l, lane);
        flash_store(vt + FL_K, [&](int rr) { return AO + (size_t)(t0 + rr) * D + hq * 64 + 64; }, sbs.o, sbs.l, lane);
    }
    {
        const int c = (tid & 63) * 8;
        float wt[3][8], bs[8];
#pragma unroll
        for (int j = 0; j < 3; ++j) { const f32x4 w0 = *(const f32x4*)(A.conv_w + j * 512 + c), w1 = *(const f32x4*)(A.conv_w + j * 512 + c + 4);
            wt[j][0] = w0.x; wt[j][1] = w0.y; wt[j][2] = w0.z; wt[j][3] = w0.w; wt[j][4] = w1.x; wt[j][5] = w1.y; wt[j][6] = w1.z; wt[j][7] = w1.w; }
        { const f32x4 b0 = *(const f32x4*)(A.conv_b + c), b1 = *(const f32x4*)(A.conv_b + c + 4); bs[0] = b0.x; bs[1] = b0.y; bs[2] = b0.z; bs[3] = b0.w; bs[4] = b1.x; bs[5] = b1.y; bs[6] = b1.z; bs[7] = b1.w; }
        const int tstride = (G * NWAVES * 64) >> 6;
#pragma unroll 2
        for (int t = (blockIdx.x * NWAVES * 64 + tid) >> 6; t < T; t += tstride) {
            const int L = t < TP ? LP : LS, pos = t & (L - 1);
            const bf16* zr = Z + (size_t)t * ODD_IN + c; const v4u bg = *(const v4u*)(zr + 768);
            const int dm = pos > 0 ? -1 : 0, dp = pos < L - 1 ? 1 : 0; const float fm = pos > 0 ? 1.f : 0.f, fp = pos < L - 1 ? 1.f : 0.f;
            const v4u cg0 = *(const v4u*)(zr + (ptrdiff_t)dm * ODD_IN + 1280), x0 = *(const v4u*)(zr + (ptrdiff_t)dm * ODD_IN + 1792);
            const v4u cg1 = *(const v4u*)(zr + 1280), x1 = *(const v4u*)(zr + 1792);
            const v4u cg2 = *(const v4u*)(zr + (ptrdiff_t)dp * ODD_IN + 1280), x2 = *(const v4u*)(zr + (ptrdiff_t)dp * ODD_IN + 1792);
            float cv[8];
#define CONV_E(e, lohi, comp) cv[e] = bs[e] + fm * wt[0][e] * (lohi(cg0.comp) * lohi(x0.comp)) + wt[1][e] * (lohi(cg1.comp) * lohi(x1.comp)) + fp * wt[2][e] * (lohi(cg2.comp) * lohi(x2.comp))
            CONV_E(0, bflo, x); CONV_E(1, bfhi, x); CONV_E(2, bflo, y); CONV_E(3, bfhi, y); CONV_E(4, bflo, z); CONV_E(5, bfhi, z); CONV_E(6, bflo, w); CONV_E(7, bfhi, w);
#undef CONV_E
            v4u o; o.x = pg8::cvt_pk_bf16(bflo(bg.x) * cv[0], bfhi(bg.x) * cv[1]); o.y = pg8::cvt_pk_bf16(bflo(bg.y) * cv[2], bfhi(bg.y) * cv[3]);
            o.z = pg8::cvt_pk_bf16(bflo(bg.z) * cv[4], bfhi(bg.z) * cv[5]); o.w = pg8::cvt_pk_bf16(bflo(bg.w) * cv[6], bfhi(bg.w) * cv[7]);
            *(v4u*)(AO + (size_t)t * D + 512 + c) = o;
        }
    }
}

#define XB_TMO      128
#define XB_XCNT(j)  (256  + 64 * (j))
#define XB_XSUB(j)  (1280 + 64 * (j))
#define XB_XGEN(j)  (2304 + 64 * (j))
#define XB_TOP      3328
#define XB_TOPGEN   3392
#define XCD_BAR_WORDS 3456
#define XB_SPIN_CAP (1u << 18)

__device__ __forceinline__ unsigned xb_ld(unsigned* p)              { return __hip_atomic_load(p, __ATOMIC_RELAXED, __HIP_MEMORY_SCOPE_AGENT); }
__device__ __forceinline__ unsigned xb_add(unsigned* p, unsigned v) { return __hip_atomic_fetch_add(p, v, __ATOMIC_RELAXED, __HIP_MEMORY_SCOPE_AGENT); }
__device__ __forceinline__ unsigned xb_xcc_id() { return (unsigned)__builtin_amdgcn_s_getreg((3 << 11) | 20) & 0xFu; }
#define XB_SPIN(cond, bar) do { unsigned _sp = 0; while (cond) { __builtin_amdgcn_s_sleep(1); \
    if ((++_sp & 255u) == 0u) { if (xb_ld(&(bar)[XB_TMO])) break; if (_sp > XB_SPIN_CAP) { atomicAdd(&(bar)[XB_TMO], 1u); break; } } } } while (0)

struct XcdBarrier {
    unsigned* bar; unsigned x;
    volatile LAS unsigned* st;
};

__device__ __forceinline__ XcdBarrier xcd_barrier_post(unsigned* bar, volatile LAS unsigned* st) {
    XcdBarrier b; b.bar = bar; b.x = xb_xcc_id(); b.st = st;
    if (my_tid() == 0) (void)xb_add(&bar[XB_XCNT(b.x)], 1u);
    return b;
}
__device__ __forceinline__ void xcd_barrier_complete(unsigned* bar, unsigned x, unsigned& nloc, unsigned& nx) {
    const unsigned G = gridDim.x * gridDim.y * gridDim.z;
    unsigned sum, cnt, mine, sp = 0u;
    for (;;) {
        sum = 0u; cnt = 0u; mine = 0u;
#pragma unroll
        for (unsigned j = 0; j < 16; ++j) { const unsigned c = xb_ld(&bar[XB_XCNT(j)]); sum += c; cnt += (c > 0u) ? 1u : 0u; mine = (j == x) ? c : mine; }
        if (sum == G) break;
        __builtin_amdgcn_s_sleep(1);
        if ((++sp & 255u) == 0u) { if (xb_ld(&bar[XB_TMO])) break; if (sp > XB_SPIN_CAP) { atomicAdd(&bar[XB_TMO], 1u); break; } }
    }
    nloc = mine > 0u ? mine : 1u; nx = cnt > 0u ? cnt : 1u;
}

__device__ __forceinline__ void xcd_barrier(const XcdBarrier& b) {
    asm volatile("s_waitcnt vmcnt(0)" ::: "memory");
    __syncthreads();
    if (my_tid() == 0) {
        unsigned* bar = b.bar;
        __builtin_amdgcn_s_waitcnt(0);
        unsigned nloc = b.st[0], nx = b.st[1];
        if (nloc == 0u) { xcd_barrier_complete(bar, b.x, nloc, nx); b.st[0] = nloc; b.st[1] = nx; }
        const unsigned old = xb_add(&bar[XB_XSUB(b.x)], 1u);
        const unsigned gen = old / nloc;
        if (old + 1u == (gen + 1u) * nloc) {
            __builtin_amdgcn_fence(__ATOMIC_RELEASE, "agent");
            asm volatile("s_waitcnt vmcnt(0)" ::: "memory");
            const unsigned og = xb_add(&bar[XB_TOP], 1u);
            const unsigned tg = og / nx;
            if (og + 1u == (tg + 1u) * nx) xb_add(&bar[XB_TOPGEN], 1u);
            else XB_SPIN(xb_ld(&bar[XB_TOPGEN]) == tg, bar);
            __builtin_amdgcn_fence(__ATOMIC_ACQUIRE, "agent");
            xb_add(&bar[XB_XGEN(b.x)], 1u);
            asm volatile("s_waitcnt vmcnt(0)" ::: "memory");
        } else {
            XB_SPIN(xb_ld(&bar[XB_XGEN(b.x)]) == gen, bar);
            __builtin_amdgcn_fence(__ATOMIC_ACQUIRE, "agent");
            asm volatile("s_waitcnt vmcnt(0)" ::: "memory");
        }
    }
    __syncthreads();
}

#if defined(__HIP_DEVICE_COMPILE__)
#define ARGS() Args A; __builtin_memcpy(&A, (const __attribute__((address_space(4))) void*)args_ptr(), sizeof(Args))
#else
#define ARGS() const Args A = Akern
#endif
#define TIDS() int tid = my_tid(); asm volatile("" : "+v"(tid)); const int lane = tid & 63, wave = __builtin_amdgcn_readfirstlane(tid >> 6); (void)lane; (void)wave
#define GRID_BAR() do { CArgsPtr ap_ = args_ptr(); XcdBarrier xb_; xb_.bar = (unsigned*)(ap_->ws + WS_CTL); xb_.x = xb_xcc_id(); xb_.st = (volatile LAS unsigned*)(lds + 143360); xcd_barrier(xb_); } while (0)
__global__ void __launch_bounds__(NWAVES * 64, 2) hybrid_fwd(Args Akern) {
    extern __shared__ __attribute__((aligned(16))) unsigned char lds_raw[];
    LAS unsigned char* lds = (LAS unsigned char*)lds_raw;
    constexpr int G = GRID;
    { const int t0_ = threadIdx.x; if ((t0_ & 63) == 0) ((volatile LAS int*)(lds + TID_TAB_OFF))[hw_slot()] = t0_ >> 6; __syncthreads(); }
    { ARGS(); TIDS(); p0_phase(A, lds, tid, lane, wave, G);
      unsigned* bw = (unsigned*)(A.ws + WS_CTL); if (blockIdx.x == 0) for (int i = tid; i < XCD_BAR_WORDS; i += NWAVES * 64) __hip_atomic_store(bw + i, 0u, __ATOMIC_RELAXED, __HIP_MEMORY_SCOPE_AGENT);
      volatile LAS unsigned* bst = (volatile LAS unsigned*)(lds + 143360);
      if (tid < 2) bst[tid] = 0u;
      cg::this_grid().sync();
      (void)xcd_barrier_post((unsigned*)(A.ws + WS_CTL), bst); }
    { ARGS(); TIDS(); p1_phase(A, lds, tid, lane, wave, G); }
    GRID_BAR();
#pragma unroll 1
    for (int layer = 0; layer < 2; ++layer) {
        {
            ARGS(); const int N = layer == 0 ? EVEN_IN : ODD_IN;
            pg8::Gemm g{(const bf16*)(A.ws + WS_HA), (const bf16*)(A.ws + (layer == 0 ? WS_WINE : WS_WINO)), T, N, D}; pg8::StaticOrder S; S.init(T, N, G, (int)blockIdx.x);
            pg8::EpiBf16R E{(bf16*)(A.ws + WS_ZR), N, layer == 0 ? 0 : 640, (const float*)(A.ws + WS_COS), (const float*)(A.ws + WS_SIN), (const float*)(A.ws + WS_S) + (size_t)(layer * 2) * T, (const float*)(A.ws + WS_SWIN) + (size_t)layer * NB * ODD_IN, ODD_IN};
            pg8::gemm_phase<pg8::EpiBf16R, pg8::StaticOrder, true, true>(lds, g, S, E);
        }
        GRID_BAR();
        { ARGS(); TIDS(); if (layer == 0) even_mixer_phase(A, lds, tid, lane, wave, G); else odd_mixer_phase(A, lds, tid, lane, wave, G); }
        GRID_BAR();
        {
            ARGS(); float* const X = A.out; const float* srcA = layer == 0 ? A.x_p : X; const float* srcB = layer == 0 ? A.x_s : X + (size_t)TP * D;
            pg8::Gemm g{(const bf16*)(A.ws + WS_HA), (const bf16*)(A.ws + (layer == 0 ? WS_WOE : WS_WOO)), T, D, D}; pg8::StaticOrder S; S.init(T, D, G, (int)blockIdx.x);
            pg8::EpiRes<true> E{srcA, srcB, X, (const float*)(A.ws + WS_MOD) + (size_t)layer * NB * 6144 + 2048, (float*)(A.ws + WS_S) + (size_t)(layer * 2 + 1) * T, (const float*)(A.ws + WS_GP) + (size_t)(layer * 2 + 1) * NB * D, (bf16*)(A.ws + WS_H2)};
            pg8::gemm_phase<pg8::EpiRes<true>, pg8::StaticOrder, true, true>(lds, g, S, E);
        }
        GRID_BAR();
        {
            ARGS();
            pg8::Gemm g{(const bf16*)(A.ws + WS_H2), (const bf16*)(A.ws + WS_W13) + (size_t)layer * 5632 * D, T, 5632, D}; pg8::StaticOrder S; S.init(T, 5632, G, (int)blockIdx.x);
            pg8::EpiSwiGLU E{(bf16*)(A.ws + WS_ZR), DFF, (const float*)(A.ws + WS_S) + (size_t)(layer * 2 + 1) * T, (const float*)(A.ws + WS_SWUP) + (size_t)layer * NB * 5632};
            pg8::gemm_phase<pg8::EpiSwiGLU, pg8::StaticOrder, true, true>(lds, g, S, E);
        }
        GRID_BAR();
        {
            ARGS(); float* const X = A.out; const float* gate = (const float*)(A.ws + WS_MOD) + (size_t)layer * NB * 6144 + 5120;
            pg8::Gemm g{(const bf16*)(A.ws + WS_ZR), (const bf16*)(A.ws + WS_W2) + (size_t)layer * D * DFF, T, D, DFF}; pg8::StaticOrder S; S.init(T, D, G, (int)blockIdx.x);
            if (layer == 0) { pg8::EpiRes<true> E{X, X + (size_t)TP * D, X, gate, (float*)(A.ws + WS_S) + (size_t)2 * T, (const float*)(A.ws + WS_GP) + (size_t)2 * NB * D, (bf16*)(A.ws + WS_HA)};
                pg8::gemm_phase<pg8::EpiRes<true>, pg8::StaticOrder, true, true>(lds, g, S, E); }
            else { pg8::EpiRes<false> E{X, X + (size_t)TP * D, X, gate, nullptr, nullptr, nullptr};
                pg8::gemm_phase<pg8::EpiRes<false>, pg8::StaticOrder, true, true>(lds, g, S, E); }
        }
        GRID_BAR();
    }
    { ARGS(); TIDS(); float* const X = A.out; const int gw = blockIdx.x * NWAVES + wave, NGW = G * NWAVES;
      for (int mrow = gw; mrow < T; mrow += NGW) {
        f32x4* xr = (f32x4*)(X + (size_t)mrow * D) + lane; f32x4 v[4]; float s = 0.f;
#pragma unroll
        for (int j = 0; j < 4; ++j) { v[j] = xr[64 * j]; s += (v[j].x * v[j].x + v[j].y * v[j].y) + (v[j].z * v[j].z + v[j].w * v[j].w); }
        const float rstd = 1.f / sqrtf(wave_sum(s) * (1.f / D) + EPS);
#pragma unroll
        for (int j = 0; j < 4; ++j) xr[64 * j] = (v[j] * rstd) * ((const f32x4*)A.final_g)[lane + 64 * j];
      } }
}

extern "C" void kernel_launch(void* const* d_in, const int* in_sizes, int n_in, void* d_out, int out_size, void* d_ws, size_t ws_size, hipStream_t stream) {
    static int grid = 0;
    if (grid == 0) {
        if (n_in != 21 || out_size != T * D || ws_size < WS_END) { fprintf(stderr, "kernel_launch: unexpected shapes (n_in %d out %d ws %zu)\n", n_in, out_size, ws_size); grid = -1; return; }
        int dev = 0, cus = 0, per_cu = 0;
        hipGetDevice(&dev); hipDeviceGetAttribute(&cus, hipDeviceAttributeMultiprocessorCount, dev);
        hipFuncSetAttribute((const void*)hybrid_fwd, hipFuncAttributeMaxDynamicSharedMemorySize, LDS_BYTES);
        if (hipOccupancyMaxActiveBlocksPerMultiprocessor(&per_cu, (const void*)hybrid_fwd, NWAVES * 64, LDS_BYTES) != hipSuccess || per_cu < 1) per_cu = 1;
        (void)hipGetLastError();
        grid = cus * per_cu;
        if (grid != GRID) { fprintf(stderr, "kernel_launch: built for a %d-workgroup resident grid, device offers %d\n", GRID, grid); grid = -1; return; }
    }
    if (grid < 0) return;
    Args a{};
    const float** p = (const float**)&a;
    for (int i = 0; i < 21; ++i) p[i] = (const float*)d_in[i];
    a.out = (float*)d_out; a.ws = (unsigned char*)d_ws;
    void* args[] = {&a};
    hipError_t e = hipLaunchCooperativeKernel((const void*)hybrid_fwd, dim3(grid), dim3(NWAVES * 64), args, LDS_BYTES, stream);
    if (e != hipSuccess) fprintf(stderr, "cooperative launch failed: %s (grid %d)\n", hipGetErrorString(e), grid);
}
```
